# Optimizing an MI355X kernel written in HIP

```python
import jax, jax.numpy as jnp
from jax import lax
import numpy as np

D_MODEL = 1024
BATCH = 2
SEQ = 8192
DEPTH = 4
DEC_BATCH = 32
DEC_SEQ = 32
PAST_LEN = 2048

CHUNK = 64
HEAD_DIM = 64
A_HEADS = 4
A_WIDTH = A_HEADS * HEAD_DIM
CONV_W = 4
LRU_C = 8.0
B_HEADS = 4
B_WIDTH = B_HEADS * HEAD_DIM
C_HEADS = 8
C_KV_HEADS = 2
C_GROUP = C_HEADS // C_KV_HEADS
C_WIDTH = C_HEADS * HEAD_DIM
C_KV_WIDTH = C_KV_HEADS * HEAD_DIM
WINDOW = 128
D_MIX = A_WIDTH + B_WIDTH + C_WIDTH
IN_SIZES = (A_WIDTH, A_WIDTH, B_WIDTH, B_WIDTH, B_WIDTH, B_WIDTH, C_WIDTH, C_KV_WIDTH, C_KV_WIDTH)
D_IN = sum(IN_SIZES)
D_FF = -(-8 * D_MODEL // (3 * 256)) * 256
ALPHA = (2.0 * DEPTH) ** 0.25
BETA = (8.0 * DEPTH) ** -0.25
LN_EPS = 1e-5
NEG = -1e30

kernel_name = 'hybrid_stream_rglru_retention_swa_step'


def layer_norm(x, g, b):
    xf = x.astype(jnp.float32)
    mu = jnp.mean(xf, axis=-1, keepdims=True)
    var = jnp.mean(jnp.square(xf - mu), axis=-1, keepdims=True)
    y = (xf - mu) * lax.rsqrt(var + LN_EPS) * g.astype(jnp.float32) + b.astype(jnp.float32)
    return y.astype(x.dtype)


def causal_conv(u, buf, w, b):
    T = u.shape[1]
    up = jnp.concatenate([buf.astype(u.dtype), u], axis=1)
    y = b + up[:, 0:T] * w[0]
    for j in range(1, CONV_W):
        y = y + up[:, j:j + T] * w[j]
    return y, up[:, T:]


def rg_lru(u, h0, w_a, b_a, w_x, b_x, lam):
    nb, T, _ = u.shape
    ub = u.reshape(nb, T, A_HEADS, HEAD_DIM)
    r = jax.nn.sigmoid(jnp.einsum('bthi,hij->bthj', ub, w_a).reshape(nb, T, A_WIDTH) + b_a)
    gi = jax.nn.sigmoid(jnp.einsum('bthi,hij->bthj', ub, w_x).reshape(nb, T, A_WIDTH) + b_x)
    log_a = -LRU_C * r.astype(jnp.float32) * jax.nn.softplus(-lam.astype(jnp.float32))
    a = jnp.exp(log_a)
    bt = jnp.sqrt(-jnp.expm1(2.0 * log_a)) * (gi * u).astype(jnp.float32)
    bt = bt.at[:, 0].add(a[:, 0] * h0.astype(jnp.float32))

    def combine(left, right):
        a_l, b_l = left
        a_r, b_r = right
        return a_l * a_r, a_r * b_l + b_r

    _, h = lax.associative_scan(combine, (a, bt), axis=1)
    return h.astype(u.dtype), h[:, -1].astype(u.dtype)


def retention_log_gamma():
    return jnp.log1p(-2.0 ** (-5.0 - jnp.arange(B_HEADS, dtype=jnp.float32)))


def retention(q, k, v, s0, chunk):
    nb, T, H, Dh = q.shape
    nc = T // chunk
    lg = retention_log_gamma()
    qc = q.reshape(nb, nc, chunk, H, Dh).astype(jnp.float32)
    kc = k.reshape(nb, nc, chunk, H, Dh).astype(jnp.float32) * Dh ** -0.5
    vc = v.reshape(nb, nc, chunk, H, Dh).astype(jnp.float32)
    idx = jnp.arange(chunk, dtype=jnp.float32)
    diff = idx[:, None] - idx[None, :]
    dmat = jnp.where(diff >= 0, jnp.exp(jnp.maximum(diff, 0.0)[None] * lg[:, None, None]), 0.0)
    inner = jnp.einsum('bnihd,bnjhd->bnhij', qc, kc) * dmat[None, None]
    o_inner = jnp.einsum('bnhij,bnjhe->bnihe', inner, vc)
    w_end = jnp.exp((chunk - 1.0 - idx)[None, :] * lg[:, None])
    u_chunk = jnp.einsum('bnjhd,hj,bnjhe->bnhde', kc, w_end, vc)
    g_chunk = jnp.exp(chunk * lg)[None, :, None, None]

    def step(s, u_n):
        return g_chunk * s + u_n, s

    s_last, s_prev = lax.scan(step, s0.astype(jnp.float32), jnp.moveaxis(u_chunk, 1, 0))
    s_prev = jnp.moveaxis(s_prev, 0, 1)
    w_start = jnp.exp((idx + 1.0)[None, :] * lg[:, None])
    o_cross = jnp.einsum('bnihd,hi,bnhde->bnihe', qc, w_start, s_prev)
    return (o_inner + o_cross).reshape(nb, T, H, Dh), s_last


def head_norm(o, g, b):
    nb, T, H, Dh = o.shape
    mu = jnp.mean(o, axis=-1, keepdims=True)
    var = jnp.mean(jnp.square(o - mu), axis=-1, keepdims=True)
    on = ((o - mu) * lax.rsqrt(var + LN_EPS)).reshape(nb, T, H * Dh)
    return on * g.astype(jnp.float32) + b.astype(jnp.float32)


def alibi_slopes():
    return 2.0 ** (-8.0 * jnp.arange(1, C_HEADS + 1, dtype=jnp.float32) / C_HEADS)


def sink_softmax(s, sink):
    m = jnp.maximum(jnp.max(s, axis=-1, keepdims=True), sink)
    e = jnp.exp(s - m)
    return e / (jnp.sum(e, axis=-1, keepdims=True) + jnp.exp(sink - m))


def swa_prompt(q, k, v, sinks):
    nb, T = q.shape[0], q.shape[1]
    nc = T // CHUNK
    nw = WINDOW // CHUNK
    kw_len = (nw + 1) * CHUNK
    qc = q.reshape(nb, nc, CHUNK, C_KV_HEADS, C_GROUP, HEAD_DIM)
    pad = ((0, 0), (nw, 0), (0, 0), (0, 0), (0, 0))
    kp = jnp.pad(k.reshape(nb, nc, CHUNK, C_KV_HEADS, HEAD_DIM), pad)
    vp = jnp.pad(v.reshape(nb, nc, CHUNK, C_KV_HEADS, HEAD_DIM), pad)
    kw = jnp.concatenate([kp[:, j:j + nc] for j in range(nw + 1)], axis=2)
    vw = jnp.concatenate([vp[:, j:j + nc] for j in range(nw + 1)], axis=2)
    s = jnp.einsum('bnqhgd,bnkhd->bnhgqk', qc, kw).astype(jnp.float32) * HEAD_DIM ** -0.5
    qpos = jnp.arange(nc)[:, None] * CHUNK + jnp.arange(CHUNK)[None, :]
    kpos = (jnp.arange(nc)[:, None] - nw) * CHUNK + jnp.arange(kw_len)[None, :]
    dist = jnp.abs(qpos[:, :, None] - kpos[:, None, :]).astype(jnp.float32)
    slopes = alibi_slopes().reshape(C_KV_HEADS, C_GROUP)
    s = s - slopes[None, None, :, :, None, None] * dist[None, :, None, None]
    s = jnp.where((kpos >= 0)[None, :, None, None, None, :], s, NEG)
    sk = sinks.astype(jnp.float32).reshape(C_KV_HEADS, C_GROUP)[None, None, :, :, None, None]
    pr = sink_softmax(s, sk)
    o = jnp.einsum('bnhgqk,bnkhd->bnqhgd', pr.astype(v.dtype), vw)
    return o.reshape(nb, T, C_WIDTH)


def swa_sample(q, k, v, k_past, v_past, sinks):
    nb, T = q.shape[0], q.shape[1]
    wc = k_past.shape[1]
    kk = jnp.concatenate([k_past.astype(k.dtype), k], axis=1)
    vv = jnp.concatenate([v_past.astype(v.dtype), v], axis=1)
    qg = q.reshape(nb, T, C_KV_HEADS, C_GROUP, HEAD_DIM)
    s = jnp.einsum('bqhgd,bkhd->bhgqk', qg, kk).astype(jnp.float32) * HEAD_DIM ** -0.5
    dist = jnp.abs((wc + jnp.arange(T))[:, None] - jnp.arange(wc + T)[None, :]).astype(jnp.float32)
    slopes = alibi_slopes().reshape(C_KV_HEADS, C_GROUP)
    s = s - slopes[None, :, :, None, None] * dist
    sk = sinks.astype(jnp.float32).reshape(C_KV_HEADS, C_GROUP)[None, :, :, None, None]
    pr = sink_softmax(s, sk)
    o = jnp.einsum('bhgqk,bkhd->bqhgd', pr.astype(v.dtype), vv)
    return o.reshape(nb, T, C_WIDTH)


def mixer(h, conv_buf, lru_h, ret_s, k_past, v_past, p, l):
    nb, T, _ = h.shape
    z = jnp.einsum('btd,de->bte', h, p['w_in'][l])
    split_at = np.cumsum(IN_SIZES)[:-1].tolist()
    ax, ag, bq, bk, bv, bg, cq, ck, cv = jnp.split(z, split_at, axis=-1)

    def heads(t, n):
        return t.reshape(nb, T, n, HEAD_DIM)

    u, conv_new = causal_conv(ax, conv_buf, p['conv_w'][l], p['conv_b'][l])
    ha, lru_new = rg_lru(u, lru_h, p['w_rg_a'][l], p['b_rg_a'][l], p['w_rg_x'][l], p['b_rg_x'][l], p['lru_lambda'][l])
    o_a = ha * jax.nn.gelu(ag)
    ro, ret_new = retention(heads(bq, B_HEADS), heads(bk, B_HEADS), heads(bv, B_HEADS), ret_s, min(CHUNK, T))
    o_b = head_norm(ro, p['ret_gn_g'][l], p['ret_gn_b'][l]).astype(h.dtype) * jax.nn.silu(bg)
    q, k, v = heads(cq, C_HEADS), heads(ck, C_KV_HEADS), heads(cv, C_KV_HEADS)
    if k_past is None:
        o_c = swa_prompt(q, k, v, p['sinks'][l])
        k_new, v_new = k[:, -WINDOW:], v[:, -WINDOW:]
    else:
        o_c = swa_sample(q, k, v, k_past, v_past, p['sinks'][l])
        k_new, v_new = k, v
    o = jnp.concatenate([o_a, o_b, o_c.astype(h.dtype)], axis=-1)
    y = jnp.einsum('bte,ed->btd', o, p['w_out'][l]).astype(h.dtype)
    return y, (conv_new, lru_new, ret_new.astype(h.dtype), k_new, v_new)


def swiglu(h, w_gate, w_up, w_down):
    a = jnp.einsum('btd,df->btf', h, w_gate)
    b = jnp.einsum('btd,df->btf', h, w_up)
    return jnp.einsum('btf,fd->btd', jax.nn.silu(a) * b, w_down).astype(h.dtype)


def trunk(x, st_conv, st_lru, st_ret, c_k, c_v, p):
    nb = x.shape[0]
    h = layer_norm(x, p['ln_in_g'], p['ln_in_b'])
    new = ([], [], [], [], [])
    for l in range(DEPTH):
        if c_k is None:
            conv_buf = jnp.zeros((nb, CONV_W - 1, A_WIDTH), h.dtype)
            lru_h = jnp.zeros((nb, A_WIDTH), h.dtype)
            ret_s = jnp.zeros((nb, B_HEADS, HEAD_DIM, HEAD_DIM), jnp.float32)
            k_past, v_past = None, None
        else:
            conv_buf, lru_h, ret_s, k_past, v_past = st_conv[l], st_lru[l], st_ret[l], c_k[l], c_v[l]
        m, states = mixer(h, conv_buf, lru_h, ret_s, k_past, v_past, p, l)
        h = layer_norm(ALPHA * h + m, p['ln1_g'][l], p['ln1_b'][l])
        f = swiglu(h, p['w_gate'][l], p['w_up'][l], p['w_down'][l])
        h = layer_norm(ALPHA * h + f, p['ln2_g'][l], p['ln2_b'][l])
        for lst, s in zip(new, states):
            lst.append(s)
    return h, tuple(jnp.stack(s) for s in new)


def setup_inputs(seed: int = 0) -> dict:
    key = jax.random.key(seed)
    ks = jax.random.split(key, 32)
    f32 = jnp.float32

    def nrm(k, shape, scale):
        return jax.random.normal(k, shape, f32) * scale

    wc = min(WINDOW, PAST_LEN)
    a_c = jax.random.uniform(ks[0], (DEPTH, A_WIDTH), f32, 0.9, 0.999)
    sig = a_c ** (1.0 / LRU_C)
    lru_lambda = jnp.log(sig) - jnp.log1p(-sig)
    return {
        'x_prompt': nrm(ks[1], (BATCH, SEQ, D_MODEL), 1.0),
        'x_sample': nrm(ks[2], (DEC_BATCH, DEC_SEQ, D_MODEL), 1.0),
        'state_conv': nrm(ks[3], (DEPTH, DEC_BATCH, CONV_W - 1, A_WIDTH), 1.0),
        'state_lru': nrm(ks[4], (DEPTH, DEC_BATCH, A_WIDTH), 0.5),
        'state_ret': nrm(ks[5], (DEPTH, DEC_BATCH, B_HEADS, HEAD_DIM, HEAD_DIM), 0.3),
        'cache_k': nrm(ks[6], (DEPTH, DEC_BATCH, wc, C_KV_HEADS, HEAD_DIM), 1.0),
        'cache_v': nrm(ks[7], (DEPTH, DEC_BATCH, wc, C_KV_HEADS, HEAD_DIM), 1.0),
        'ln_in_g': 1.0 + nrm(ks[8], (D_MODEL,), 0.02),
        'ln_in_b': nrm(ks[9], (D_MODEL,), 0.02),
        'w_in': nrm(ks[10], (DEPTH, D_MODEL, D_IN), D_MODEL ** -0.5),
        'conv_w': nrm(ks[11], (DEPTH, CONV_W, A_WIDTH), CONV_W ** -0.5),
        'conv_b': nrm(ks[12], (DEPTH, A_WIDTH), 0.02),
        'w_rg_a': nrm(ks[13], (DEPTH, A_HEADS, HEAD_DIM, HEAD_DIM), HEAD_DIM ** -0.5),
        'b_rg_a': nrm(ks[14], (DEPTH, A_WIDTH), 0.02),
        'w_rg_x': nrm(ks[15], (DEPTH, A_HEADS, HEAD_DIM, HEAD_DIM), HEAD_DIM ** -0.5),
        'b_rg_x': nrm(ks[16], (DEPTH, A_WIDTH), 0.02),
        'lru_lambda': lru_lambda,
        'ret_gn_g': 1.0 + nrm(ks[17], (DEPTH, B_WIDTH), 0.02),
        'ret_gn_b': nrm(ks[18], (DEPTH, B_WIDTH), 0.02),
        'sinks': nrm(ks[19], (DEPTH, C_HEADS), 0.5),
        'w_out': nrm(ks[20], (DEPTH, D_MIX, D_MODEL), D_MIX ** -0.5 * BETA),
        'ln1_g': 1.0 + nrm(ks[21], (DEPTH, D_MODEL), 0.02),
        'ln1_b': nrm(ks[22], (DEPTH, D_MODEL), 0.02),
        'w_gate': nrm(ks[23], (DEPTH, D_MODEL, D_FF), D_MODEL ** -0.5),
        'w_up': nrm(ks[24], (DEPTH, D_MODEL, D_FF), D_MODEL ** -0.5),
        'w_down': nrm(ks[25], (DEPTH, D_FF, D_MODEL), D_FF ** -0.5 * BETA),
        'ln2_g': 1.0 + nrm(ks[26], (DEPTH, D_MODEL), 0.02),
        'ln2_b': nrm(ks[27], (DEPTH, D_MODEL), 0.02),
    }


def reference(x_prompt, x_sample, state_conv, state_lru, state_ret, cache_k, cache_v,
              ln_in_g, ln_in_b, w_in, conv_w, conv_b, w_rg_a, b_rg_a, w_rg_x, b_rg_x, lru_lambda,
              ret_gn_g, ret_gn_b, sinks, w_out, ln1_g, ln1_b, w_gate, w_up, w_down, ln2_g, ln2_b):
    p = {'ln_in_g': ln_in_g, 'ln_in_b': ln_in_b, 'w_in': w_in, 'conv_w': conv_w, 'conv_b': conv_b,
         'w_rg_a': w_rg_a, 'b_rg_a': b_rg_a, 'w_rg_x': w_rg_x, 'b_rg_x': b_rg_x, 'lru_lambda': lru_lambda,
         'ret_gn_g': ret_gn_g, 'ret_gn_b': ret_gn_b, 'sinks': sinks, 'w_out': w_out,
         'ln1_g': ln1_g, 'ln1_b': ln1_b, 'w_gate': w_gate, 'w_up': w_up, 'w_down': w_down,
         'ln2_g': ln2_g, 'ln2_b': ln2_b}
    y_prompt, (p_conv, p_lru, p_ret, p_k, p_v) = trunk(x_prompt, None, None, None, None, None, p)
    y_sample, (s_conv, s_lru, s_ret, s_k, s_v) = trunk(x_sample, state_conv, state_lru, state_ret, cache_k, cache_v, p)
    return (y_prompt, y_sample, p_conv, p_lru, p_ret, p_k, p_v, s_conv, s_lru, s_ret, s_k, s_v)
```

```cpp
#include <hip/hip_runtime.h>
#include <hip/hip_cooperative_groups.h>
#include <cstdio>
#include <cstdint>
namespace cg = cooperative_groups;
namespace pg8 {
#define PG8_LAS __attribute__((address_space(3)))
typedef unsigned short bf16_t;
typedef short bf16x8 __attribute__((ext_vector_type(8)));
typedef float f32x4 __attribute__((ext_vector_type(4)));
typedef unsigned u32x4 __attribute__((ext_vector_type(4)));
constexpr int BM = 256, BK = 64, HALF = 128, HTB = HALF * BK * 2  , STAGE_BYTES = 8 * HTB, NXCD = 8, WGM = 8;

__host__ __device__ __forceinline__ int lds_byte(int r, int c) { const int st = (r >> 4) * 2 + (c >> 5), rr = r & 15, cc = c & 31, ob = rr * 64 + cc * 2; return st * 1024 + (ob ^ (((ob >> 9) & 1) << 5)); }
__host__ __device__ __forceinline__ void stage_rc(int b, int& R, int& C) { const int st = b / 1024, sb = b % 1024, swz = sb ^ (((sb >> 9) & 1) << 5); R = (st >> 1) * 16 + swz / 64; C = (st & 1) * 32 + (swz % 64) / 2; }
__host__ __device__ __forceinline__ int perm32(int rho) { const int n = rho >> 4, i = rho & 15; return 8 * (i >> 2) + 4 * n + (i & 3); }

struct Unit { int pm, pn; };
struct Gemm { const bf16_t* A; const bf16_t* Bt; int M, N, K; };

struct StaticOrder {
    int nM, nN, nwg, G, c;
    __host__ __device__ void init(int M, int N, int G_, int c_) { nM = M / BM; nN = N / BM; nwg = nM * nN; G = G_; c = c_; }
    __host__ __device__ bool next(int i, Unit& u) const {
        const long L = (long)i * G + c; if (L >= nwg) return false;
        int wgid = (int)L; { const int q = nwg / NXCD, r = nwg % NXCD, xcd = wgid % NXCD, off = wgid / NXCD; wgid = (xcd < r ? xcd * (q + 1) : r * (q + 1) + (xcd - r) * q) + off; }
        const int nig = WGM * nN, gid = wgid / nig, fm = gid * WGM, gsz = (nM - fm) < WGM ? (nM - fm) : WGM;
        u.pm = fm + ((wgid % nig) % gsz); u.pn = (wgid % nig) / gsz; return true;
    }
    __device__ __forceinline__ void a_ready(const Unit&) const {}
    __device__ __forceinline__ void done(const Unit&) const {}
};
__device__ __forceinline__ unsigned cvt_pk_bf16(float lo, float hi) { unsigned r; asm volatile("v_cvt_pk_bf16_f32 %0, %1, %2" : "=v"(r) : "v"(lo), "v"(hi)); return r; }
typedef unsigned u32x2 __attribute__((ext_vector_type(2)));
struct EpiZ {
    static constexpr bool PERM = true, AFTER_DRAIN = false;
    bf16_t* O; int ldc;
    __device__ __forceinline__ void operator()(const f32x4 (&acc)[2][2][4][2], const Unit& u, int wr, int wc, int fr, int fq) const {
        const int row0 = u.pm * BM + wr * 64 + fr; const int col0 = u.pn * BM + wc * 32 + 8 * fq;
#pragma unroll
        for (int ai = 0; ai < 2; ++ai)
#pragma unroll
            for (int m = 0; m < 4; ++m) { bf16_t* rowp = O + (size_t)(row0 + ai * HALF + m * 16) * ldc + col0;
#pragma unroll
                for (int bj = 0; bj < 2; ++bj) { const f32x4 v0 = acc[ai][bj][m][0], v1 = acc[ai][bj][m][1];
                    u32x4 w; w.x = cvt_pk_bf16(v0[0], v0[1]); w.y = cvt_pk_bf16(v0[2], v0[3]); w.z = cvt_pk_bf16(v1[0], v1[1]); w.w = cvt_pk_bf16(v1[2], v1[3]);
                    *(u32x4*)(rowp + bj * HALF) = w; } }
    }
};
struct EpiGU {
    static constexpr bool PERM = true, AFTER_DRAIN = false;
    bf16_t* G; int ldg;
    __device__ __forceinline__ void operator()(const f32x4 (&acc)[2][2][4][2], const Unit& u, int wr, int wc, int fr, int fq) const {
        const int row0 = u.pm * BM + wr * 64 + fr; const int col0 = u.pn * (BM / 2) + wc * 16 + 4 * fq;
#pragma unroll
        for (int ai = 0; ai < 2; ++ai)
#pragma unroll
            for (int m = 0; m < 4; ++m) { bf16_t* rowp = G + (size_t)(row0 + ai * HALF + m * 16) * ldg + col0;
#pragma unroll
                for (int bj = 0; bj < 2; ++bj) { const f32x4 g = acc[ai][bj][m][0], up = acc[ai][bj][m][1]; f32x4 r;
#pragma unroll
                    for (int i = 0; i < 4; ++i) r[i] = g[i] / (1.0f + __expf(-g[i])) * up[i];
                    u32x2 w; w.x = cvt_pk_bf16(r[0], r[1]); w.y = cvt_pk_bf16(r[2], r[3]);
                    *(u32x2*)(rowp + bj * (HALF / 2)) = w; } }
    }
};
struct EpiRes {
    static constexpr bool PERM = false, AFTER_DRAIN = false;
    float* H; int ldc; float alpha;
    __device__ __forceinline__ void operator()(const f32x4 (&acc)[2][2][4][2], const Unit& u, int wr, int wc, int fr, int fq) const {
        const int row0 = u.pm * BM + wr * 64 + fr; const int col0 = u.pn * BM + wc * 32 + 4 * fq;
#pragma unroll
        for (int ai = 0; ai < 2; ++ai)
#pragma unroll
            for (int m = 0; m < 4; ++m) { float* rowp = H + (size_t)(row0 + ai * HALF + m * 16) * ldc + col0;
#pragma unroll
                for (int bj = 0; bj < 2; ++bj)
#pragma unroll
                    for (int n = 0; n < 2; ++n) { f32x4* p = (f32x4*)(rowp + bj * HALF + n * 16); const f32x4 b = *p; *p = b * alpha + acc[ai][bj][m][n]; } }
    }
};
template <class Epi, class Sched, bool ALIGN_EPI = false, bool SP2 = false>
__device__ __forceinline__ void gemm_phase(PG8_LAS unsigned char* lds, const Gemm g, const Sched& S, const Epi& E) {
    int tid_ = threadIdx.x; asm volatile("" : "+v"(tid_));
    const int tid = tid_, wid = __builtin_amdgcn_readfirstlane(tid >> 6), lane = tid & 63, wr = wid >> 2, wc = wid & 3, fr = lane & 15, fq = lane >> 4;
    const int K = g.K, nt = K / BK;
    unsigned voffA[2], voffB[2];
#pragma unroll
    for (int i = 0; i < 2; ++i) { int R, C; stage_rc(tid * 16 + i * 8192, R, C); const int Rb = Epi::PERM ? ((R & ~31) + perm32(R & 31)) : R;
        voffA[i] = (unsigned)(R * K + C) * 2u; voffB[i] = (unsigned)(Rb * K + C) * 2u; }
    const size_t kstep = (size_t)(BK * 2);
    const size_t hstep = (size_t)HALF * K * 2;
    const size_t tstep = 2 * hstep;
    const unsigned ldsw = (unsigned)wid * 1024u;
    const int aoff = lds_byte(wr * 64 + fr, fq * 8), boff = lds_byte(wc * 32 + fr, fq * 8);
#define PG8_SA(b, h) (((b) * 2 + (h)) * HTB)
#define PG8_SB(b, h) ((4 + (b) * 2 + (h)) * HTB)
#define PG8_STAGE(bufoff, gbase, voff) do { _Pragma("unroll") for (int _i = 0; _i < 2; ++_i) \
        __builtin_amdgcn_global_load_lds((const unsigned*)((const char*)(gbase) + (voff)[_i]), (PG8_LAS unsigned*)(lds + (bufoff) + ldsw + _i * 8192), 16, 0, 0); } while (0)
#define PG8_LDA(dst, b, h) do { _Pragma("unroll") for (int m = 0; m < 4; ++m) _Pragma("unroll") for (int k = 0; k < 2; ++k) dst[m][k] = *(const PG8_LAS bf16x8*)(lds + PG8_SA(b, h) + aoff + m * 2048 + k * 1024); } while (0)
#define PG8_LDB(dst, b, h) do { _Pragma("unroll") for (int n = 0; n < 2; ++n) _Pragma("unroll") for (int k = 0; k < 2; ++k) dst[n][k] = *(const PG8_LAS bf16x8*)(lds + PG8_SB(b, h) + boff + n * 2048 + k * 1024); } while (0)
#define PG8_MMA(ai, bj, At, Bt) do { __builtin_amdgcn_s_setprio(1); _Pragma("unroll") for (int m = 0; m < 4; ++m) _Pragma("unroll") for (int n = 0; n < 2; ++n) _Pragma("unroll") for (int k = 0; k < 2; ++k) \
        acc[ai][bj][m][n] = __builtin_amdgcn_mfma_f32_16x16x32_bf16(Bt[n][k], At[m][k], acc[ai][bj][m][n], 0, 0, 0); __builtin_amdgcn_s_setprio(0); } while (0)
#define PG8_WAIT_V(n) asm volatile("s_waitcnt vmcnt(" #n ")" ::: "memory")
#define PG8_WAIT_L(n) asm volatile("s_waitcnt lgkmcnt(" #n ")" ::: "memory")
#define PG8_BAR __builtin_amdgcn_s_barrier()
#define PG8_SCHED __builtin_amdgcn_sched_barrier(0)
    Unit cur, nxt; int ui = 0;
    if (!S.next(0, cur)) return;
    f32x4 acc[2][2][4][2];
#pragma unroll
    for (int a = 0; a < 2; ++a)
#pragma unroll
        for (int b = 0; b < 2; ++b)
#pragma unroll
            for (int m = 0; m < 4; ++m)
#pragma unroll
                for (int n = 0; n < 2; ++n) acc[a][b][m][n] = (f32x4){0.f, 0.f, 0.f, 0.f};
    bf16x8 At[4][2], B0[2][2], B1[2][2];
    const char* cA = (const char*)g.A + (size_t)cur.pm * tstep; const char* cB = (const char*)g.Bt + (size_t)cur.pn * tstep;
    S.a_ready(cur);
    if constexpr (SP2) {
        PG8_STAGE(PG8_SB(0, 0), cB, voffB); PG8_STAGE(PG8_SB(0, 1), cB + hstep, voffB); PG8_STAGE(PG8_SA(0, 0), cA, voffA); PG8_STAGE(PG8_SA(0, 1), cA + hstep, voffA);
        if (wr == 1) PG8_BAR;
        PG8_WAIT_V(2); PG8_BAR;
        PG8_STAGE(PG8_SB(1, 0), cB + kstep, voffB); PG8_STAGE(PG8_SA(1, 0), cA + kstep, voffA); PG8_STAGE(PG8_SB(1, 1), cB + hstep + kstep, voffB);
        PG8_WAIT_V(6); PG8_BAR;
    } else {
        PG8_STAGE(PG8_SB(0, 0), cB, voffB); PG8_STAGE(PG8_SA(0, 0), cA, voffA); PG8_STAGE(PG8_SB(0, 1), cB + hstep, voffB); PG8_STAGE(PG8_SA(0, 1), cA + hstep, voffA);
        if (wr == 1) PG8_BAR;
        PG8_WAIT_V(4); PG8_BAR;
        PG8_STAGE(PG8_SB(1, 0), cB + kstep, voffB); PG8_STAGE(PG8_SA(1, 0), cA + kstep, voffA); PG8_STAGE(PG8_SB(1, 1), cB + hstep + kstep, voffB);
        PG8_WAIT_V(6); PG8_BAR;
    }
    for (;;) {
        const bool has_next = S.next(ui + 1, nxt);
        const char* nA = has_next ? (const char*)g.A + (size_t)nxt.pm * tstep : cA; const char* nB = has_next ? (const char*)g.Bt + (size_t)nxt.pn * tstep : cB;
        for (int t = 0; t < nt; t += 2) {
            const bool last = (t == nt - 2);
            const char* a1 = cA + (size_t)(t + 1) * kstep;
            const char* a2 = last ? nA : cA + (size_t)(t + 2) * kstep; const char* b2 = last ? nB : cB + (size_t)(t + 2) * kstep;
            const char* a3 = a2 + kstep; const char* b3 = b2 + kstep;
            if (last && has_next) S.a_ready(nxt);
            if constexpr (SP2) {
            PG8_LDB(B0, 0, 0); PG8_LDB(B1, 0, 1); PG8_SCHED; PG8_LDA(At, 0, 0); PG8_STAGE(PG8_SA(1, 1), a1 + hstep, voffA);
            PG8_WAIT_V(8); PG8_WAIT_L(0); PG8_BAR; PG8_MMA(0, 0, At, B0); PG8_MMA(0, 1, At, B1); PG8_BAR; PG8_SCHED;
            PG8_LDA(At, 0, 1); PG8_STAGE(PG8_SB(0, 0), b2, voffB); PG8_STAGE(PG8_SB(0, 1), b2 + hstep, voffB); PG8_STAGE(PG8_SA(0, 0), a2, voffA);
            PG8_WAIT_V(8); PG8_WAIT_L(0); PG8_BAR; PG8_MMA(1, 0, At, B0); PG8_MMA(1, 1, At, B1); PG8_BAR; PG8_SCHED;
            PG8_LDB(B0, 1, 0); PG8_LDB(B1, 1, 1); PG8_SCHED; PG8_LDA(At, 1, 0); PG8_STAGE(PG8_SA(0, 1), a2 + hstep, voffA);
            PG8_WAIT_V(8); PG8_WAIT_L(0); PG8_BAR; PG8_MMA(0, 0, At, B0); PG8_MMA(0, 1, At, B1); PG8_BAR; PG8_SCHED;
            PG8_LDA(At, 1, 1); PG8_STAGE(PG8_SB(1, 0), b3, voffB); PG8_STAGE(PG8_SB(1, 1), b3 + hstep, voffB); PG8_STAGE(PG8_SA(1, 0), a3, voffA);
            PG8_WAIT_V(8); PG8_WAIT_L(0); PG8_BAR; PG8_MMA(1, 0, At, B0); PG8_MMA(1, 1, At, B1); PG8_BAR; PG8_SCHED;
            } else {
            PG8_LDB(B0, 0, 0); PG8_SCHED; PG8_LDA(At, 0, 0); PG8_STAGE(PG8_SA(1, 1), a1 + hstep, voffA);
            PG8_WAIT_L(8); PG8_BAR; PG8_WAIT_L(0); PG8_MMA(0, 0, At, B0); PG8_BAR; PG8_SCHED;
            PG8_LDB(B1, 0, 1); PG8_STAGE(PG8_SB(0, 0), b2, voffB);
            PG8_BAR; PG8_WAIT_L(0); PG8_MMA(0, 1, At, B1); PG8_BAR;
            PG8_LDA(At, 0, 1); PG8_STAGE(PG8_SA(0, 0), a2, voffA);
            PG8_BAR; PG8_WAIT_L(0); PG8_MMA(1, 0, At, B0); PG8_BAR; PG8_SCHED;
            PG8_STAGE(PG8_SB(0, 1), b2 + hstep, voffB);
            PG8_WAIT_V(6); PG8_BAR; PG8_MMA(1, 1, At, B1); PG8_BAR;
            PG8_LDB(B0, 1, 0); PG8_SCHED; PG8_LDA(At, 1, 0); PG8_STAGE(PG8_SA(0, 1), a2 + hstep, voffA);
            PG8_WAIT_L(8); PG8_BAR; PG8_WAIT_L(0); PG8_MMA(0, 0, At, B0); PG8_BAR; PG8_SCHED;
            PG8_LDB(B1, 1, 1); PG8_STAGE(PG8_SB(1, 0), b3, voffB);
            PG8_BAR; PG8_WAIT_L(0); PG8_MMA(0, 1, At, B1); PG8_BAR;
            PG8_LDA(At, 1, 1); PG8_STAGE(PG8_SA(1, 0), a3, voffA);
            PG8_BAR; PG8_WAIT_L(0); PG8_MMA(1, 0, At, B0); PG8_BAR; PG8_SCHED;
            PG8_STAGE(PG8_SB(1, 1), b3 + hstep, voffB);
            PG8_WAIT_V(6); PG8_BAR; PG8_MMA(1, 1, At, B1); PG8_BAR;
            }
        }
        if constexpr (ALIGN_EPI) { if (wr == 0) PG8_BAR; }
        if constexpr (!Epi::AFTER_DRAIN) { E(acc, cur, wr, wc, fr, fq); S.done(cur); }
        if (!has_next) break;
#pragma unroll
        for (int a = 0; a < 2; ++a)
#pragma unroll
            for (int b = 0; b < 2; ++b)
#pragma unroll
                for (int m = 0; m < 4; ++m)
#pragma unroll
                    for (int n = 0; n < 2; ++n) acc[a][b][m][n] = (f32x4){0.f, 0.f, 0.f, 0.f};
        cur = nxt; cA = nA; cB = nB; ++ui;
        if constexpr (ALIGN_EPI) { if (wr == 1) PG8_BAR; }
    }
    PG8_WAIT_V(0);
    if constexpr (!ALIGN_EPI) { if (wr == 0) PG8_BAR; }
    PG8_BAR;
    if constexpr (Epi::AFTER_DRAIN) { E.fused(acc, cur, wr, wc, fr, fq, lds, wid, lane); S.done(cur); }
#undef PG8_SA
#undef PG8_SB
#undef PG8_STAGE
#undef PG8_LDA
#undef PG8_LDB
#undef PG8_MMA
#undef PG8_WAIT_V
#undef PG8_WAIT_L
#undef PG8_BAR
#undef PG8_SCHED
}
}

typedef unsigned short bf16;
typedef short bf16x8 __attribute__((ext_vector_type(8)));
typedef float f32x4 __attribute__((ext_vector_type(4)));
typedef unsigned u32x4 __attribute__((ext_vector_type(4)));
typedef unsigned u32x2 __attribute__((ext_vector_type(2)));
typedef float f32x2_t __attribute__((ext_vector_type(2)));
typedef __bf16 bf16x2_t __attribute__((ext_vector_type(2)));
#define DI __device__ __forceinline__
#define LAS __attribute__((address_space(3)))

constexpr int DM = 1024, MTOK = 17408, MP = 16384, DIN = 2304, DFF = 2816, NL = 4, ZS = DIN;
constexpr int C_AX = 0, C_AG = 256, C_BQ = 512, C_BK = 768, C_BV = 1024, C_BG = 1280, C_CQ = 1536, C_CK = 2048, C_CV = 2176;
constexpr int NCT = 288;
constexpr float LN_EPS = 1e-5f;
constexpr float ALPHA = 1.681792830507429f;
constexpr int LDS_BYTES = 147456;
enum { I_XP = 0, I_XS, I_SCONV, I_SLRU, I_SRET, I_CK, I_CV, I_LNG, I_LNB, I_WIN, I_CONVW, I_CONVB, I_WRA, I_BRA, I_WRX, I_BRX, I_LAM, I_GNG, I_GNB, I_SINK, I_WOUT,
       I_LN1G, I_LN1B, I_WG, I_WU, I_WD, I_LN2G, I_LN2B, N_IN };
constexpr size_t O_Y = 0, O_PCONV = 17825792, O_PLRU = 17831936, O_PRET = 17833984, O_PK = 17965056, O_PV = 18096128, O_SCONV = 18227200, O_SLRU = 18325504,
                 O_SRET = 18358272, O_SK = 20455424, O_SV = 20979712, O_END = 21504000;
constexpr size_t WL_IN = 0, WL_OUT = 4718592, WL_GU = 6815744, WL_D = 18350080, WL_BYTES = 24117248;
constexpr size_t WS_W = 0, WS_OHB = 96468992, WS_Z = 132120576, WS_HLOC = 212336640, WS_PC = 230162432, WS_U = 247988224, WS_AS = 266862592, WS_BS = 267157504, WS_END = 267452416;
constexpr size_t WS_G = WS_Z;

struct KArgs { const float* in[N_IN]; float* out; unsigned char* ws; };

DI int otid() { int t = threadIdx.x; asm volatile("" : "+v"(t)); return t; }
constexpr int TBL_OFF = 131072 + 1024;
DI const float* inp_(const unsigned char* lds, int i) {
    const LAS unsigned* t = (const LAS unsigned*)((const LAS unsigned char*)lds + TBL_OFF) + 2 * i;
    const unsigned lo = __builtin_amdgcn_readfirstlane(t[0]), hi = __builtin_amdgcn_readfirstlane(t[1]);
    return (const float*)(((unsigned long long)hi << 32) | (unsigned long long)lo);
}
#define INP(i) inp_(lds, (i))
DI float bf2f(bf16 v) { return __uint_as_float((unsigned)v << 16); }
DI unsigned pk2(float lo, float hi) { f32x2_t v = {lo, hi}; bf16x2_t b = __builtin_convertvector(v, bf16x2_t); return __builtin_bit_cast(unsigned, b); }
DI bf16x8 pack8(f32x4 a, f32x4 b) { u32x4 p; p.x = pk2(a[0], a[1]); p.y = pk2(a[2], a[3]); p.z = pk2(b[0], b[1]); p.w = pk2(b[2], b[3]); return __builtin_bit_cast(bf16x8, p); }
DI float sigmoidf_(float x) { return 1.0f / (1.0f + __expf(-x)); }
DI float gelu_tanh(float x) { const float y = 0.7978845608028654f * (x + 0.044715f * x * x * x); const float t = 1.0f - 2.0f / (__expf(2.0f * y) + 1.0f); return 0.5f * x * (1.0f + t); }
DI float wave_sum(float v) {
#pragma unroll
    for (int o = 1; o < 64; o <<= 1) v += __shfl_xor(v, o);
    return v;
}
#define MFMA16(a, b, c) __builtin_amdgcn_mfma_f32_16x16x32_bf16((a), (b), (c), 0, 0, 0)

DI void p0_transpose_item(const float* W, int K, int N, bf16* WT, int mode, LAS float* scr, int item, int lane) {
    const int nblk = N / 32, kb = item / nblk, nb = item % nblk, k0 = 64 * kb, n0 = 32 * nb;
#pragma unroll 8
    for (int i = 0; i < 32; ++i) { const int kk = 2 * i + (lane >> 5); scr[kk * 33 + (lane & 31)] = W[(size_t)(k0 + kk) * N + n0 + (lane & 31)]; }
    asm volatile("s_waitcnt lgkmcnt(0)" ::: "memory");
    const int c = lane & 7;
#pragma unroll
    for (int j = 0; j < 4; ++j) { const int n = (lane >> 3) + 8 * j; const LAS float* s = scr + (8 * c) * 33 + n;
        u32x4 o; o.x = pk2(s[0 * 33], s[1 * 33]); o.y = pk2(s[2 * 33], s[3 * 33]); o.z = pk2(s[4 * 33], s[5 * 33]); o.w = pk2(s[6 * 33], s[7 * 33]);
        const int ng = n0 + n; const int row = mode == 0 ? ng : ((ng >> 2) * 8 + (ng & 3) + (mode == 2 ? 4 : 0));
        *(u32x4*)(WT + (size_t)row * K + k0 + 8 * c) = o; }
    asm volatile("s_waitcnt lgkmcnt(0)" ::: "memory");
}
DI void ln_row(const float* xrow, const float* g, const float* b, float* hrow, bf16* hbrow, int lane) {
    const f32x4* xr = (const f32x4*)xrow + lane;
    f32x4 v[4]; float s = 0.f;
#pragma unroll
    for (int j = 0; j < 4; ++j) { v[j] = xr[64 * j]; s += (v[j].x + v[j].y) + (v[j].z + v[j].w); }
    const float mean = wave_sum(s) * (1.f / DM); float s2 = 0.f;
#pragma unroll
    for (int j = 0; j < 4; ++j) { v[j] = v[j] - mean; s2 += (v[j].x * v[j].x + v[j].y * v[j].y) + (v[j].z * v[j].z + v[j].w * v[j].w); }
    const float rstd = 1.f / sqrtf(wave_sum(s2) * (1.f / DM) + LN_EPS);
#pragma unroll
    for (int j = 0; j < 4; ++j) { const f32x4 gg = ((const f32x4*)g)[lane + 64 * j], bb = ((const f32x4*)b)[lane + 64 * j];
        const f32x4 y = v[j] * rstd * gg + bb; ((f32x4*)hrow)[lane + 64 * j] = y;
        if (hbrow) { u32x2 w; w.x = pk2(y.x, y.y); w.y = pk2(y.z, y.w); ((u32x2*)hbrow)[lane + 64 * j] = w; } }
}
DI void phase_p0(const KArgs& a, unsigned char* lds, int wave, int lane) {
    LAS float* scr = (LAS float*)((LAS unsigned char*)lds + wave * 16384);
    const int gw = blockIdx.x * 8 + wave, NGW = gridDim.x * 8;
    constexpr int I_IN = 16 * 72, I_OUT = 16 * 32, I_GT = 16 * 88, I_DN = 44 * 32, I_LAYER = I_IN + I_OUT + 2 * I_GT + I_DN;
    for (int it = gw; it < NL * I_LAYER; it += NGW) {
        const int l = it / I_LAYER; int r = it % I_LAYER; unsigned char* wl = a.ws + WS_W + (size_t)l * WL_BYTES;
        if (r < I_IN) { p0_transpose_item(INP(I_WIN) + (size_t)l * DM * DIN, DM, DIN, (bf16*)(wl + WL_IN), 0, scr, r, lane); continue; } r -= I_IN;
        if (r < I_OUT) { p0_transpose_item(INP(I_WOUT) + (size_t)l * DM * DM, DM, DM, (bf16*)(wl + WL_OUT), 0, scr, r, lane); continue; } r -= I_OUT;
        if (r < I_GT) { p0_transpose_item(INP(I_WG) + (size_t)l * DM * DFF, DM, DFF, (bf16*)(wl + WL_GU), 1, scr, r, lane); continue; } r -= I_GT;
        if (r < I_GT) { p0_transpose_item(INP(I_WU) + (size_t)l * DM * DFF, DM, DFF, (bf16*)(wl + WL_GU), 2, scr, r, lane); continue; } r -= I_GT;
        p0_transpose_item(INP(I_WD) + (size_t)l * DFF * DM, DFF, DM, (bf16*)(wl + WL_D), 0, scr, r, lane);
    }
    float* h = a.out + O_Y; bf16* hb = (bf16*)(a.ws + WS_OHB);
    for (int m = gw; m < MTOK; m += NGW) {
        const float* xrow = m < MP ? INP(I_XP) + (size_t)m * DM : INP(I_XS) + (size_t)(m - MP) * DM;
        ln_row(xrow, INP(I_LNG), INP(I_LNB), h + (size_t)m * DM, hb + (size_t)m * DM, lane);
    }
}
DI void phase_ln(const KArgs& a, const float* g, const float* b, bool want_bf16, int wave, int lane) {
    const int gw = blockIdx.x * 8 + wave, NGW = gridDim.x * 8;
    float* h = a.out + O_Y; bf16* hb = (bf16*)(a.ws + WS_OHB);
    for (int m = gw; m < MTOK; m += NGW) ln_row(h + (size_t)m * DM, g, b, h + (size_t)m * DM, want_bf16 ? hb + (size_t)m * DM : nullptr, lane);
}

struct CT { int row0, L, b, n, sb; bool sample; };
DI CT ct_decode(int ct) { CT c; if (ct < 256) { c.sample = false; c.b = ct >> 7; c.n = ct & 127; c.sb = 0; c.row0 = c.b * 8192 + c.n * 64; c.L = 64; }
                          else { c.sample = true; c.sb = ct - 256; c.b = 0; c.n = 0; c.row0 = MP + c.sb * 32; c.L = 32; } return c; }
DI float lg2_gamma(int h) { return __log2f(1.0f - exp2f(-5.0f - (float)h)); }

DI void m1_a_item(const KArgs& a, int l, int ct, unsigned char* lds) {
    const int tid = otid(), c = tid & 255, half = tid >> 8, t0 = half * 32;
    const CT k = ct_decode(ct);
    float* us = (float*)lds;
    float* ex = us + 64 * 256;
    const bf16* z = (const bf16*)(a.ws + WS_Z);
    const bf16* zc = z + (size_t)k.row0 * ZS + C_AX + c;
    const bool active = t0 < k.L;
    const float* cw = INP(I_CONVW) + (size_t)l * 4 * 256 + c;
    const float cw0 = cw[0], cw1 = cw[256], cw2 = cw[512], cw3 = cw[768], cb = INP(I_CONVB)[l * 256 + c];
    float x0 = 0.f, x1 = 0.f, x2 = 0.f;
    if (active) {
        if (t0 == 0) {
            if (!k.sample) { if (k.n != 0) { x0 = bf2f(zc[-3 * ZS]); x1 = bf2f(zc[-2 * ZS]); x2 = bf2f(zc[-1 * ZS]); } }
            else { const float* sc = INP(I_SCONV) + ((size_t)(l * 32 + k.sb) * 3) * 256 + c; x0 = sc[0]; x1 = sc[256]; x2 = sc[512]; }
        } else { x0 = bf2f(zc[(t0 - 3) * ZS]); x1 = bf2f(zc[(t0 - 2) * ZS]); x2 = bf2f(zc[(t0 - 1) * ZS]); }
#pragma unroll 8
        for (int t = 0; t < 32; ++t) { const float x3 = bf2f(zc[(size_t)(t0 + t) * ZS]); us[(t0 + t) * 256 + c] = cb + cw0 * x0 + cw1 * x1 + cw2 * x2 + cw3 * x3; x0 = x1; x1 = x2; x2 = x3; }
        if (!k.sample && k.n == 127 && half == 1) { float* o = a.out + O_PCONV + ((size_t)(l * 2 + k.b) * 3) * 256 + c; o[0] = x0; o[256] = x1; o[512] = x2; }
        if (k.sample) { float* o = a.out + O_SCONV + ((size_t)(l * 32 + k.sb) * 3) * 256 + c; o[0] = x0; o[256] = x1; o[512] = x2; }
    }
    __syncthreads();
    float ar[32], ax[32];
#pragma unroll
    for (int t = 0; t < 32; ++t) { ar[t] = 0.f; ax[t] = 0.f; }
    if (active) {
        const int hh = c >> 6, j = c & 63;
        const float* Wa = INP(I_WRA) + ((size_t)(l * 4 + hh) * 64) * 64 + j;
        const float* Wx = INP(I_WRX) + ((size_t)(l * 4 + hh) * 64) * 64 + j;
#pragma unroll 1
        for (int i = 0; i < 64; i += 4) {
            const float wa0 = Wa[(i + 0) * 64], wa1 = Wa[(i + 1) * 64], wa2 = Wa[(i + 2) * 64], wa3 = Wa[(i + 3) * 64];
            const float wx0 = Wx[(i + 0) * 64], wx1 = Wx[(i + 1) * 64], wx2 = Wx[(i + 2) * 64], wx3 = Wx[(i + 3) * 64];
#pragma unroll
            for (int t = 0; t < 32; ++t) { const f32x4 u4 = *(const f32x4*)&us[(t0 + t) * 256 + hh * 64 + i];
                ar[t] += u4.x * wa0 + u4.y * wa1 + u4.z * wa2 + u4.w * wa3; ax[t] += u4.x * wx0 + u4.y * wx1 + u4.z * wx2 + u4.w * wx3;
                if ((t & 7) == 7) __builtin_amdgcn_sched_barrier(0); }
        }
        const float ba = INP(I_BRA)[l * 256 + c], bx = INP(I_BRX)[l * 256 + c];
        const float sp = log1pf(expf(-INP(I_LAM)[l * 256 + c]));
        float P = 1.f, hl = 0.f;
#pragma unroll
        for (int t = 0; t < 32; ++t) { const float r = sigmoidf_(ar[t] + ba), gi = sigmoidf_(ax[t] + bx); const float la = -8.0f * r * sp; const float av = expf(la);
            const float bt = sqrtf(fmaxf(-expm1f(2.0f * la), 0.f)) * gi * us[(t0 + t) * 256 + c]; hl = av * hl + bt; P *= av; ar[t] = P; ax[t] = hl; }
        if (half == 0) { ex[c] = P; ex[256 + c] = hl; }
    }
    __syncthreads();
    if (active) {
        if (half == 1) { const float P0 = ex[c], h0 = ex[256 + c];
#pragma unroll
            for (int t = 0; t < 32; ++t) { ax[t] += ar[t] * h0; ar[t] *= P0; } }
        float* hloc = (float*)(a.ws + WS_HLOC) + (size_t)(k.row0 + t0) * 256 + c; float* pc = (float*)(a.ws + WS_PC) + (size_t)(k.row0 + t0) * 256 + c;
#pragma unroll
        for (int t = 0; t < 32; ++t) { hloc[t * 256] = ax[t]; pc[t * 256] = ar[t]; }
        float* As = (float*)(a.ws + WS_AS) + ct * 256 + c; float* Bs = (float*)(a.ws + WS_BS) + ct * 256 + c;
        if (!k.sample && half == 1) { *As = ar[31]; *Bs = ax[31]; }
        if (k.sample) { const float h0s = INP(I_SLRU)[(size_t)(l * 32 + k.sb) * 256 + c]; a.out[O_SLRU + (size_t)(l * 32 + k.sb) * 256 + c] = ar[31] * h0s + ax[31]; *As = ar[31]; *Bs = h0s; }
    }
    __syncthreads();
}

DI void m1_u_item(const KArgs& a, int l, int ct, unsigned char* lds) {
    const int tid = otid(), lane = tid & 63, w = tid >> 6;
    const CT k = ct_decode(ct);
    float* kw = (float*)lds;
    float* vv = kw + 4 * 64 * 64;
    const bf16* z = (const bf16*)(a.ws + WS_Z);
    { const int cp = tid & 127, js = tid >> 7, hh = cp >> 5, d = 2 * (cp & 31); const float lg = lg2_gamma(hh);
      for (int j = js; j < k.L; j += 4) {
          const bf16* zr = z + (size_t)(k.row0 + j) * ZS;
          const unsigned kk = *(const unsigned*)(zr + C_BK + 2 * cp), vx = *(const unsigned*)(zr + C_BV + 2 * cp);
          const float wj = exp2f((float)(k.L - 1 - j) * lg) * 0.125f;
          kw[(hh * 64 + j) * 64 + d] = __uint_as_float(kk << 16) * wj; kw[(hh * 64 + j) * 64 + d + 1] = __uint_as_float(kk & 0xffff0000u) * wj;
          vv[(hh * 64 + j) * 64 + d] = __uint_as_float(vx << 16); vv[(hh * 64 + j) * 64 + d + 1] = __uint_as_float(vx & 0xffff0000u); } }
    __syncthreads();
    const int hh = w >> 1, dh = (w & 1) * 32;
    float acc[32];
#pragma unroll
    for (int i = 0; i < 32; ++i) acc[i] = 0.f;
#pragma unroll 2
    for (int j = 0; j < k.L; ++j) { const float ve = vv[(hh * 64 + j) * 64 + lane];
#pragma unroll
        for (int dd = 0; dd < 32; dd += 4) { const f32x4 k4 = *(const f32x4*)&kw[(hh * 64 + j) * 64 + dh + dd]; acc[dd] += k4.x * ve; acc[dd + 1] += k4.y * ve; acc[dd + 2] += k4.z * ve; acc[dd + 3] += k4.w * ve; } }
    if (!k.sample) { float* U = (float*)(a.ws + WS_U) + ((size_t)(ct * 4 + hh) * 64 + dh) * 64 + lane;
#pragma unroll
        for (int dd = 0; dd < 32; ++dd) U[dd * 64] = acc[dd]; }
    else { const size_t base = (((size_t)(l * 32 + k.sb) * 4 + hh) * 64 + dh) * 64 + lane; const float g32 = exp2f(32.0f * lg2_gamma(hh));
        const float* s0 = INP(I_SRET) + base; float* o = a.out + O_SRET + base;
#pragma unroll
        for (int dd = 0; dd < 32; ++dd) o[dd * 64] = g32 * s0[dd * 64] + acc[dd]; }
    __syncthreads();
}

constexpr int VS = 200;
template <bool SAMPLE> DI void m1_swa_item(const KArgs& a, int l, int ct, int kh, unsigned char* lds) {
    constexpr int NQT = SAMPLE ? 1 : 2, NKT = SAMPLE ? 10 : 12, NK = NKT * 16;
    const int tid = otid(), lane = tid & 63, w = tid >> 6, fr = lane & 15, fq = lane >> 4;
    const CT k = ct_decode(ct);
    bf16* VT = (bf16*)lds;
    const bf16* z = (const bf16*)(a.ws + WS_Z);
    const int seq0 = k.n * 64 - 128;
    for (int p = tid; p < NK * 8; p += 512) {
        const int key = p >> 3, d0 = (p & 7) * 8; u32x4 raw = (u32x4){0u, 0u, 0u, 0u};
        if constexpr (!SAMPLE) { if (seq0 + key >= 0) raw = *(const u32x4*)(z + (size_t)(k.b * 8192 + seq0 + key) * ZS + C_CV + kh * 64 + d0); }
        else { if (key < 128) { const float* cv = INP(I_CV) + (((size_t)(l * 32 + k.sb) * 128 + key) * 2 + kh) * 64 + d0; const f32x4 f0 = *(const f32x4*)cv, f1 = *(const f32x4*)(cv + 4);
                   raw.x = pk2(f0.x, f0.y); raw.y = pk2(f0.z, f0.w); raw.z = pk2(f1.x, f1.y); raw.w = pk2(f1.z, f1.w); }
               else raw = *(const u32x4*)(z + (size_t)(k.row0 + key - 128) * ZS + C_CV + kh * 64 + d0); }
        bf16* dst = VT + (size_t)d0 * VS + key;
        dst[0 * VS] = (bf16)(raw.x & 0xffffu); dst[1 * VS] = (bf16)(raw.x >> 16); dst[2 * VS] = (bf16)(raw.y & 0xffffu); dst[3 * VS] = (bf16)(raw.y >> 16);
        dst[4 * VS] = (bf16)(raw.z & 0xffffu); dst[5 * VS] = (bf16)(raw.z >> 16); dst[6 * VS] = (bf16)(raw.w & 0xffffu); dst[7 * VS] = (bf16)(raw.w >> 16);
    }
    __syncthreads();
    const int g = w >> 1, qbase = (w & 1) * (NQT * 16), hd = kh * 4 + g;
    const float slope = exp2f(-(float)(hd + 1)), sink = INP(I_SINK)[l * 8 + hd];
    bf16x8 qf[NQT][2];
#pragma unroll
    for (int qt = 0; qt < NQT; ++qt)
#pragma unroll
        for (int kk = 0; kk < 2; ++kk) qf[qt][kk] = *(const bf16x8*)(z + (size_t)(k.row0 + qbase + qt * 16 + fr) * ZS + C_CQ + hd * 64 + kk * 32 + fq * 8);
    f32x4 S[NQT][NKT];
#pragma unroll
    for (int kt = 0; kt < NKT; ++kt) {
        const int key = kt * 16 + fr; bf16x8 kf[2];
        if constexpr (!SAMPLE) { const int sp = seq0 + key; const bf16* kr = z + (size_t)(k.b * 8192 + (sp < 0 ? 0 : sp)) * ZS + C_CK + kh * 64 + fq * 8;
            kf[0] = *(const bf16x8*)kr; kf[1] = *(const bf16x8*)(kr + 32); }
        else { if (kt < 8) { const float* ck = INP(I_CK) + (((size_t)(l * 32 + k.sb) * 128 + key) * 2 + kh) * 64 + fq * 8;
                   kf[0] = pack8(*(const f32x4*)ck, *(const f32x4*)(ck + 4)); kf[1] = pack8(*(const f32x4*)(ck + 32), *(const f32x4*)(ck + 36)); }
               else { const bf16* kr = z + (size_t)(k.row0 + key - 128) * ZS + C_CK + kh * 64 + fq * 8; kf[0] = *(const bf16x8*)kr; kf[1] = *(const bf16x8*)(kr + 32); } }
#pragma unroll
        for (int qt = 0; qt < NQT; ++qt) { f32x4 s = (f32x4){0.f, 0.f, 0.f, 0.f}; s = MFMA16(kf[0], qf[qt][0], s); s = MFMA16(kf[1], qf[qt][1], s); S[qt][kt] = s; }
    }
    bf16x8 pf[NQT][NKT / 2];
#pragma unroll
    for (int qt = 0; qt < NQT; ++qt) {
        const int qi = qbase + qt * 16 + fr; float m = -3.0e38f;
#pragma unroll
        for (int kt = 0; kt < NKT; ++kt)
#pragma unroll
            for (int jj = 0; jj < 4; ++jj) { const int key = kt * 16 + fq * 4 + jj; const float dist = fabsf((float)(128 + qi - key)); float s = S[qt][kt][jj] * 0.125f - slope * dist;
                if constexpr (!SAMPLE) { if (seq0 + key < 0) s = -1e30f; }
                S[qt][kt][jj] = s; m = fmaxf(m, s); }
        m = fmaxf(m, __shfl_xor(m, 16)); m = fmaxf(m, __shfl_xor(m, 32)); m = fmaxf(m, sink);
        float sum = 0.f;
#pragma unroll
        for (int kt = 0; kt < NKT; ++kt)
#pragma unroll
            for (int jj = 0; jj < 4; ++jj) { const float e = __expf(S[qt][kt][jj] - m); S[qt][kt][jj] = e; sum += e; }
        sum += __shfl_xor(sum, 16); sum += __shfl_xor(sum, 32);
        const float inv = 1.0f / (sum + __expf(sink - m));
#pragma unroll
        for (int kb = 0; kb < NKT / 2; ++kb) pf[qt][kb] = pack8(S[qt][2 * kb] * inv, S[qt][2 * kb + 1] * inv);
    }
    bf16* ob = (bf16*)(a.ws + WS_OHB);
#pragma unroll
    for (int dt = 0; dt < 4; ++dt) {
        f32x4 o[NQT];
#pragma unroll
        for (int qt = 0; qt < NQT; ++qt) o[qt] = (f32x4){0.f, 0.f, 0.f, 0.f};
#pragma unroll
        for (int kb = 0; kb < NKT / 2; ++kb) {
            const bf16* vp = VT + (size_t)(dt * 16 + fr) * VS + kb * 32 + fq * 4;
            u32x4 vr; const u32x2 v0 = *(const u32x2*)vp, v1 = *(const u32x2*)(vp + 16); vr.x = v0.x; vr.y = v0.y; vr.z = v1.x; vr.w = v1.y;
            const bf16x8 vf = __builtin_bit_cast(bf16x8, vr);
#pragma unroll
            for (int qt = 0; qt < NQT; ++qt) o[qt] = MFMA16(vf, pf[qt][kb], o[qt]);
        }
#pragma unroll
        for (int qt = 0; qt < NQT; ++qt) { u32x2 wv; wv.x = pk2(o[qt][0], o[qt][1]); wv.y = pk2(o[qt][2], o[qt][3]);
            *(u32x2*)(ob + (size_t)(k.row0 + qbase + qt * 16 + fr) * DM + 512 + hd * 64 + dt * 16 + fq * 4) = wv; }
    }
    __syncthreads();
}

DI void phase_m1(const KArgs& a, int l, unsigned char* lds) {
    for (int it = blockIdx.x; it < 1152; it += gridDim.x) {
        if (it < 576) { const int ct = it >> 1, kh = it & 1; if (ct < 256) m1_swa_item<false>(a, l, ct, kh, lds); else m1_swa_item<true>(a, l, ct, kh, lds); }
        else if (it < 864) m1_a_item(a, l, it - 576, lds);
        else m1_u_item(a, l, it - 864, lds);
    }
}

DI void phase_m2(const KArgs& a, int l, unsigned char* lds) {
    const int tid = otid(), bx = blockIdx.x;
    if (bx == 0) {
        const int b = tid >> 8, c = tid & 255; float* As = (float*)(a.ws + WS_AS) + (size_t)(b * 128) * 256 + c; float* Bs = (float*)(a.ws + WS_BS) + (size_t)(b * 128) * 256 + c;
        float H = 0.f;
#pragma unroll 1
        for (int n = 0; n < 128; n += 8) { float av[8], bv[8];
#pragma unroll
            for (int i = 0; i < 8; ++i) { av[i] = As[(n + i) * 256]; bv[i] = Bs[(n + i) * 256]; }
#pragma unroll
            for (int i = 0; i < 8; ++i) { Bs[(n + i) * 256] = H; H = av[i] * H + bv[i]; } }
        a.out[O_PLRU + (size_t)(l * 2 + b) * 256 + c] = H;
    } else if (bx <= 64) {
        const int e = (bx - 1) * 512 + tid, b = e >> 14, rem = e & 16383, hh = rem >> 12, de = rem & 4095;
        const float g = exp2f(64.0f * lg2_gamma(hh));
        float* U = (float*)(a.ws + WS_U) + ((size_t)(b * 128) * 4 + hh) * 4096 + de; float s = 0.f;
#pragma unroll 1
        for (int n = 0; n < 128; n += 8) { float uv[8];
#pragma unroll
            for (int i = 0; i < 8; ++i) uv[i] = U[(size_t)(n + i) * 16384];
#pragma unroll
            for (int i = 0; i < 8; ++i) { U[(size_t)(n + i) * 16384] = s; s = g * s + uv[i]; } }
        a.out[O_PRET + ((size_t)(l * 2 + b) * 4 + hh) * 4096 + de] = s;
    } else {
        const bf16* z = (const bf16*)(a.ws + WS_Z);
        for (int i = (bx - 65) * 512 + tid; i < 1280 * 64; i += (gridDim.x - 65) * 512) {
            const int r = i >> 6, c4 = (i & 63) * 4; int zrow; float* ok;
            if (r < 256) { const int b = r >> 7, w = r & 127; zrow = b * 8192 + 8064 + w; ok = a.out + (c4 < 128 ? O_PK : O_PV) + ((size_t)(l * 2 + b) * 128 + w) * 128; }
            else { const int rs = r - 256; zrow = MP + rs; ok = a.out + (c4 < 128 ? O_SK : O_SV) + ((size_t)l * 1024 + rs) * 128; }
            const u32x2 raw = *(const u32x2*)(z + (size_t)zrow * ZS + C_CK + c4);
            f32x4 o; o.x = __uint_as_float(raw.x << 16); o.y = __uint_as_float(raw.x & 0xffff0000u); o.z = __uint_as_float(raw.y << 16); o.w = __uint_as_float(raw.y & 0xffff0000u);
            *(f32x4*)(ok + (c4 & 127)) = o;
        }
    }
}

constexpr int TS = 72;
template <bool SAMPLE> DI void m3_item(const KArgs& a, int l, int ct, unsigned char* lds) {
    constexpr int L = SAMPLE ? 32 : 64, NIT = SAMPLE ? 1 : 2, NJT = L / 16;
    const int tid = otid(), lane = tid & 63, w = tid >> 6, fr = lane & 15, fq = lane >> 4;
    const CT k = ct_decode(ct);
    const bf16* z = (const bf16*)(a.ws + WS_Z);
    bf16* ob = (bf16*)(a.ws + WS_OHB);
    bf16* VT = (bf16*)lds;
    bf16* ST = VT + 4 * 64 * TS;
    { const int c4 = (tid & 63) * 4; const f32x4 hin = *(const f32x4*)((const float*)(a.ws + WS_BS) + ct * 256 + c4);
      for (int t = tid >> 6; t < L; t += 8) { const size_t r = (size_t)(k.row0 + t);
          const f32x4 hl = *(const f32x4*)((const float*)(a.ws + WS_HLOC) + r * 256 + c4), pc = *(const f32x4*)((const float*)(a.ws + WS_PC) + r * 256 + c4);
          const u32x2 ag = *(const u32x2*)(z + r * ZS + C_AG + c4);
          const f32x4 hv = hl + pc * hin;
          u32x2 o; o.x = pk2(hv.x * gelu_tanh(__uint_as_float(ag.x << 16)), hv.y * gelu_tanh(__uint_as_float(ag.x & 0xffff0000u)));
          o.y = pk2(hv.z * gelu_tanh(__uint_as_float(ag.y << 16)), hv.w * gelu_tanh(__uint_as_float(ag.y & 0xffff0000u)));
          *(u32x2*)(ob + r * DM + c4) = o; } }
    for (int p = tid; p < L * 32; p += 512) { const int j = p >> 5, col = (p & 31) * 8;
        const u32x4 raw = *(const u32x4*)(z + (size_t)(k.row0 + j) * ZS + C_BV + col); bf16* dst = VT + (size_t)col * TS + j;
        dst[0 * TS] = (bf16)(raw.x & 0xffffu); dst[1 * TS] = (bf16)(raw.x >> 16); dst[2 * TS] = (bf16)(raw.y & 0xffffu); dst[3 * TS] = (bf16)(raw.y >> 16);
        dst[4 * TS] = (bf16)(raw.z & 0xffffu); dst[5 * TS] = (bf16)(raw.z >> 16); dst[6 * TS] = (bf16)(raw.w & 0xffffu); dst[7 * TS] = (bf16)(raw.w >> 16); }
    { const float* Sp = SAMPLE ? INP(I_SRET) + (size_t)(l * 32 + k.sb) * 16384 : (const float*)(a.ws + WS_U) + (size_t)ct * 16384;
      for (int p = tid; p < 4096; p += 512) { const int hh = p >> 10, d = (p >> 4) & 63, e0 = (p & 15) * 4; const f32x4 s = *(const f32x4*)(Sp + (size_t)(hh * 64 + d) * 64 + e0);
          bf16* dst = ST + (size_t)(hh * 64 + e0) * TS + d; const unsigned p0 = pk2(s.x, s.y), p1 = pk2(s.z, s.w);
          dst[0 * TS] = (bf16)(p0 & 0xffffu); dst[1 * TS] = (bf16)(p0 >> 16); dst[2 * TS] = (bf16)(p1 & 0xffffu); dst[3 * TS] = (bf16)(p1 >> 16); } }
    __syncthreads();
    const int hh = w >> 1, half = w & 1; const float lg = lg2_gamma(hh);
    bf16x8 qf[NIT][2];
#pragma unroll
    for (int it = 0; it < NIT; ++it)
#pragma unroll
        for (int kk = 0; kk < 2; ++kk) qf[it][kk] = *(const bf16x8*)(z + (size_t)(k.row0 + half * (NIT * 16) + it * 16 + fr) * ZS + C_BQ + hh * 64 + kk * 32 + fq * 8);
    bf16x8 pf[NIT][NJT / 2];
    {   f32x4 S[NIT][NJT];
#pragma unroll
        for (int jt = 0; jt < NJT; ++jt) { const bf16* kr = z + (size_t)(k.row0 + jt * 16 + fr) * ZS + C_BK + hh * 64 + fq * 8;
            const bf16x8 kf0 = *(const bf16x8*)kr, kf1 = *(const bf16x8*)(kr + 32);
#pragma unroll
            for (int it = 0; it < NIT; ++it) { f32x4 s = (f32x4){0.f, 0.f, 0.f, 0.f}; s = MFMA16(kf0, qf[it][0], s); s = MFMA16(kf1, qf[it][1], s);
                const int i = half * (NIT * 16) + it * 16 + fr;
#pragma unroll
                for (int jj = 0; jj < 4; ++jj) { const int dij = i - (jt * 16 + fq * 4 + jj); s[jj] = dij >= 0 ? s[jj] * 0.125f * exp2f((float)dij * lg) : 0.f; }
                S[it][jt] = s; } }
#pragma unroll
        for (int it = 0; it < NIT; ++it)
#pragma unroll
            for (int jb = 0; jb < NJT / 2; ++jb) pf[it][jb] = pack8(S[it][2 * jb], S[it][2 * jb + 1]);
    }
    f32x4 o[NIT][4];
#pragma unroll
    for (int et = 0; et < 4; ++et) {
        f32x4 oi[NIT], oc[NIT];
#pragma unroll
        for (int it = 0; it < NIT; ++it) { oi[it] = (f32x4){0.f, 0.f, 0.f, 0.f}; oc[it] = (f32x4){0.f, 0.f, 0.f, 0.f}; }
#pragma unroll
        for (int jb = 0; jb < NJT / 2; ++jb) { const bf16* vp = VT + (size_t)(hh * 64 + et * 16 + fr) * TS + jb * 32 + fq * 4;
            u32x4 vr; const u32x2 v0 = *(const u32x2*)vp, v1 = *(const u32x2*)(vp + 16); vr.x = v0.x; vr.y = v0.y; vr.z = v1.x; vr.w = v1.y; const bf16x8 vf = __builtin_bit_cast(bf16x8, vr);
#pragma unroll
            for (int it = 0; it < NIT; ++it) oi[it] = MFMA16(vf, pf[it][jb], oi[it]); }
#pragma unroll
        for (int kk = 0; kk < 2; ++kk) { const bf16x8 sf = *(const bf16x8*)(ST + (size_t)(hh * 64 + et * 16 + fr) * TS + kk * 32 + fq * 8);
#pragma unroll
            for (int it = 0; it < NIT; ++it) oc[it] = MFMA16(sf, qf[it][kk], oc[it]); }
#pragma unroll
        for (int it = 0; it < NIT; ++it) { const int i = half * (NIT * 16) + it * 16 + fr; o[it][et] = oi[it] + oc[it] * exp2f((float)(i + 1) * lg); }
    }
#pragma unroll
    for (int it = 0; it < NIT; ++it) {
        const int i = half * (NIT * 16) + it * 16 + fr; const size_t r = (size_t)(k.row0 + i);
        float s = 0.f;
#pragma unroll
        for (int et = 0; et < 4; ++et) s += (o[it][et][0] + o[it][et][1]) + (o[it][et][2] + o[it][et][3]);
        s += __shfl_xor(s, 16); s += __shfl_xor(s, 32);
        const float mean = s * (1.0f / 64.0f); float q = 0.f;
#pragma unroll
        for (int et = 0; et < 4; ++et) { o[it][et] = o[it][et] - mean; q += (o[it][et][0] * o[it][et][0] + o[it][et][1] * o[it][et][1]) + (o[it][et][2] * o[it][et][2] + o[it][et][3] * o[it][et][3]); }
        q += __shfl_xor(q, 16); q += __shfl_xor(q, 32);
        const float rstd = 1.0f / sqrtf(q * (1.0f / 64.0f) + LN_EPS);
#pragma unroll
        for (int et = 0; et < 4; ++et) { const int e = hh * 64 + et * 16 + fq * 4;
            const f32x4 gg = *(const f32x4*)(INP(I_GNG) + l * 256 + e), bb = *(const f32x4*)(INP(I_GNB) + l * 256 + e);
            const u32x2 bgr = *(const u32x2*)(z + r * ZS + C_BG + e);
            const float g0 = __uint_as_float(bgr.x << 16), g1 = __uint_as_float(bgr.x & 0xffff0000u), g2 = __uint_as_float(bgr.y << 16), g3 = __uint_as_float(bgr.y & 0xffff0000u);
            const f32x4 y = o[it][et] * rstd * gg + bb;
            u32x2 wv; wv.x = pk2(y.x * g0 * sigmoidf_(g0), y.y * g1 * sigmoidf_(g1)); wv.y = pk2(y.z * g2 * sigmoidf_(g2), y.w * g3 * sigmoidf_(g3));
            *(u32x2*)(ob + r * DM + 256 + e) = wv; }
    }
    __syncthreads();
}
DI void phase_m3(const KArgs& a, int l, unsigned char* lds) {
    for (int ct = blockIdx.x; ct < NCT; ct += gridDim.x) { if (ct < 256) m3_item<false>(a, l, ct, lds); else m3_item<true>(a, l, ct, lds); }
}

__global__ void __launch_bounds__(512, 2) fwd_kernel(KArgs a) {
    extern __shared__ __attribute__((aligned(16))) unsigned char lds[];
    cg::grid_group grid = cg::this_grid();
    const int tid = otid(), lane = tid & 63, wave = __builtin_amdgcn_readfirstlane(tid >> 6);
    const int G = gridDim.x, bx = blockIdx.x;
    if (tid == 0) { LAS unsigned long long* tb = (LAS unsigned long long*)((LAS unsigned char*)lds + TBL_OFF);
#pragma unroll
        for (int i = 0; i < N_IN; ++i) tb[i] = (unsigned long long)a.in[i]; }
    __syncthreads();
    phase_p0(a, lds, wave, lane);
    grid.sync();
    bf16* ohb = (bf16*)(a.ws + WS_OHB);
#pragma unroll 1
    for (int l = 0; l < NL; ++l) {
        unsigned char* wl = a.ws + WS_W + (size_t)l * WL_BYTES;
        {
            pg8::Gemm g{ohb, (const bf16*)(wl + WL_IN), MTOK, DIN, DM}; pg8::StaticOrder S; S.init(MTOK, DIN, G, bx);
            pg8::EpiZ E{(bf16*)(a.ws + WS_Z), DIN};
            pg8::gemm_phase<pg8::EpiZ, pg8::StaticOrder, true, true>((LAS unsigned char*)lds, g, S, E);
        }
        grid.sync();
        phase_m1(a, l, lds);
        grid.sync();
        phase_m2(a, l, lds);
        grid.sync();
        phase_m3(a, l, lds);
        grid.sync();
        {
            pg8::Gemm g{ohb, (const bf16*)(wl + WL_OUT), MTOK, DM, DM}; pg8::StaticOrder S; S.init(MTOK, DM, G, bx);
            pg8::EpiRes E{a.out + O_Y, DM, ALPHA};
            pg8::gemm_phase<pg8::EpiRes, pg8::StaticOrder, true, true>((LAS unsigned char*)lds, g, S, E);
        }
        grid.sync();
        phase_ln(a, INP(I_LN1G) + l * DM, INP(I_LN1B) + l * DM, true, wave, lane);
        grid.sync();
        {
            pg8::Gemm g{ohb, (const bf16*)(wl + WL_GU), MTOK, 2 * DFF, DM}; pg8::StaticOrder S; S.init(MTOK, 2 * DFF, G, bx);
            pg8::EpiGU E{(bf16*)(a.ws + WS_G), DFF};
            pg8::gemm_phase<pg8::EpiGU, pg8::StaticOrder, true, true>((LAS unsigned char*)lds, g, S, E);
        }
        grid.sync();
        {
            pg8::Gemm g{(const bf16*)(a.ws + WS_G), (const bf16*)(wl + WL_D), MTOK, DM, DFF}; pg8::StaticOrder S; S.init(MTOK, DM, G, bx);
            pg8::EpiRes E{a.out + O_Y, DM, ALPHA};
            pg8::gemm_phase<pg8::EpiRes, pg8::StaticOrder, true, true>((LAS unsigned char*)lds, g, S, E);
        }
        grid.sync();
        phase_ln(a, INP(I_LN2G) + l * DM, INP(I_LN2B) + l * DM, l + 1 < NL, wave, lane);
        if (l + 1 < NL) grid.sync();
    }
}

extern "C" void kernel_launch(void* const* d_in, const int* in_sizes, int n_in, void* d_out, int out_size, void* d_ws, size_t ws_size, hipStream_t stream) {
    static int grid = 0;
    if (grid == 0) {
        if (n_in != N_IN || out_size != (int)O_END || ws_size < WS_END) { fprintf(stderr, "kernel_launch: unexpected sizes n_in %d out %d ws %zu\n", n_in, out_size, ws_size); grid = -1; return; }
        int dev = 0, cus = 0, per_cu = 0;
        if (hipGetDevice(&dev) != hipSuccess || hipDeviceGetAttribute(&cus, hipDeviceAttributeMultiprocessorCount, dev) != hipSuccess) { grid = -1; return; }
        if (hipFuncSetAttribute((const void*)fwd_kernel, hipFuncAttributeMaxDynamicSharedMemorySize, LDS_BYTES) != hipSuccess) { fprintf(stderr, "kernel_launch: hipFuncSetAttribute failed\n"); grid = -1; return; }
        if (hipOccupancyMaxActiveBlocksPerMultiprocessor(&per_cu, (const void*)fwd_kernel, 512, LDS_BYTES) != hipSuccess || per_cu < 1) { fprintf(stderr, "kernel_launch: occupancy query says %d\n", per_cu); per_cu = 1; }
        (void)hipGetLastError();
        grid = cus;
    }
    if (grid < 0) return;
    KArgs a{};
    for (int i = 0; i < N_IN; ++i) a.in[i] = (const float*)d_in[i];
    a.out = (float*)d_out; a.ws = (unsigned char*)d_ws;
    void* args[] = {&a};
    hipError_t e = hipLaunchCooperativeKernel((const void*)fwd_kernel, dim3(grid), dim3(512), args, LDS_BYTES, stream);
    if (e != hipSuccess) fprintf(stderr, "cooperative launch failed: %s (grid %d)\n", hipGetErrorString(e), grid);
}
```

```cpp
#include <hip/hip_runtime.h>
#include <hip/hip_cooperative_groups.h>
#include <cstdio>
#include <cstdint>
namespace cg = cooperative_groups;
namespace pg8 {
#define PG8_LAS __attribute__((address_space(3)))
typedef unsigned short bf16_t;
typedef short bf16x8 __attribute__((ext_vector_type(8)));
typedef float f32x4 __attribute__((ext_vector_type(4)));
typedef unsigned u32x4 __attribute__((ext_vector_type(4)));
constexpr int BM = 256, BK = 64, HALF = 128, HTB = HALF * BK * 2  , STAGE_BYTES = 8 * HTB, NXCD = 8, WGM = 8;

__host__ __device__ __forceinline__ int lds_byte(int r, int c) { const int st = (r >> 4) * 2 + (c >> 5), rr = r & 15, cc = c & 31, ob = rr * 64 + cc * 2; return st * 1024 + (ob ^ (((ob >> 9) & 1) << 5)); }
__host__ __device__ __forceinline__ void stage_rc(int b, int& R, int& C) { const int st = b / 1024, sb = b % 1024, swz = sb ^ (((sb >> 9) & 1) << 5); R = (st >> 1) * 16 + swz / 64; C = (st & 1) * 32 + (swz % 64) / 2; }
__host__ __device__ __forceinline__ int perm32(int rho) { const int n = rho >> 4, i = rho & 15; return 8 * (i >> 2) + 4 * n + (i & 3); }

struct Unit { int pm, pn; };
struct Gemm { const bf16_t* A; const bf16_t* Bt; int M, N, K; };

struct StaticOrder {
    int nM, nN, nwg, G, c;
    __host__ __device__ void init(int M, int N, int G_, int c_) { nM = M / BM; nN = N / BM; nwg = nM * nN; G = G_; c = c_; }
    __host__ __device__ bool next(int i, Unit& u) const {
        const long L = (long)i * G + c; if (L >= nwg) return false;
        int wgid = (int)L; { const int q = nwg / NXCD, r = nwg % NXCD, xcd = wgid % NXCD, off = wgid / NXCD; wgid = (xcd < r ? xcd * (q + 1) : r * (q + 1) + (xcd - r) * q) + off; }
        const int nig = WGM * nN, gid = wgid / nig, fm = gid * WGM, gsz = (nM - fm) < WGM ? (nM - fm) : WGM;
        u.pm = fm + ((wgid % nig) % gsz); u.pn = (wgid % nig) / gsz; return true;
    }
    __device__ __forceinline__ void a_ready(const Unit&) const {}
    __device__ __forceinline__ void done(const Unit&) const {}
};
__device__ __forceinline__ unsigned cvt_pk_bf16(float lo, float hi) { unsigned r; asm volatile("v_cvt_pk_bf16_f32 %0, %1, %2" : "=v"(r) : "v"(lo), "v"(hi)); return r; }
typedef unsigned u32x2 __attribute__((ext_vector_type(2)));
struct EpiZ {
    static constexpr bool PERM = true, AFTER_DRAIN = false;
    bf16_t* O; int ldc;
    __device__ __forceinline__ void operator()(const f32x4 (&acc)[2][2][4][2], const Unit& u, int wr, int wc, int fr, int fq) const {
        const int row0 = u.pm * BM + wr * 64 + fr; const int col0 = u.pn * BM + wc * 32 + 8 * fq;
#pragma unroll
        for (int ai = 0; ai < 2; ++ai)
#pragma unroll
            for (int m = 0; m < 4; ++m) { bf16_t* rowp = O + (size_t)(row0 + ai * HALF + m * 16) * ldc + col0;
#pragma unroll
                for (int bj = 0; bj < 2; ++bj) { const f32x4 v0 = acc[ai][bj][m][0], v1 = acc[ai][bj][m][1];
                    u32x4 w; w.x = cvt_pk_bf16(v0[0], v0[1]); w.y = cvt_pk_bf16(v0[2], v0[3]); w.z = cvt_pk_bf16(v1[0], v1[1]); w.w = cvt_pk_bf16(v1[2], v1[3]);
                    *(u32x4*)(rowp + bj * HALF) = w; } }
    }
};
struct EpiGU {
    static constexpr bool PERM = true, AFTER_DRAIN = false;
    bf16_t* G; int ldg;
    __device__ __forceinline__ void operator()(const f32x4 (&acc)[2][2][4][2], const Unit& u, int wr, int wc, int fr, int fq) const {
        const int row0 = u.pm * BM + wr * 64 + fr; const int col0 = u.pn * (BM / 2) + wc * 16 + 4 * fq;
#pragma unroll
        for (int ai = 0; ai < 2; ++ai)
#pragma unroll
            for (int m = 0; m < 4; ++m) { bf16_t* rowp = G + (size_t)(row0 + ai * HALF + m * 16) * ldg + col0;
#pragma unroll
                for (int bj = 0; bj < 2; ++bj) { const f32x4 g = acc[ai][bj][m][0], up = acc[ai][bj][m][1]; f32x4 r;
#pragma unroll
                    for (int i = 0; i < 4; ++i) r[i] = g[i] / (1.0f + __expf(-g[i])) * up[i];
                    u32x2 w; w.x = cvt_pk_bf16(r[0], r[1]); w.y = cvt_pk_bf16(r[2], r[3]);
                    *(u32x2*)(rowp + bj * (HALF / 2)) = w; } }
    }
};
struct EpiRes {
    static constexpr bool PERM = false, AFTER_DRAIN = false;
    float* H; int ldc; float alpha;
    __device__ __forceinline__ void operator()(const f32x4 (&acc)[2][2][4][2], const Unit& u, int wr, int wc, int fr, int fq) const {
        const int row0 = u.pm * BM + wr * 64 + fr; const int col0 = u.pn * BM + wc * 32 + 4 * fq;
#pragma unroll
        for (int ai = 0; ai < 2; ++ai)
#pragma unroll
            for (int m = 0; m < 4; ++m) { float* rowp = H + (size_t)(row0 + ai * HALF + m * 16) * ldc + col0;
#pragma unroll
                for (int bj = 0; bj < 2; ++bj)
#pragma unroll
                    for (int n = 0; n < 2; ++n) { f32x4* p = (f32x4*)(rowp + bj * HALF + n * 16); const f32x4 b = *p; *p = b * alpha + acc[ai][bj][m][n]; } }
    }
};
template <class Epi, class Sched, bool ALIGN_EPI = false, bool SP2 = false>
__device__ __forceinline__ void gemm_phase(PG8_LAS unsigned char* lds, const Gemm g, const Sched& S, const Epi& E) {
    int tid_ = threadIdx.x; asm volatile("" : "+v"(tid_));
    const int tid = tid_, wid = __builtin_amdgcn_readfirstlane(tid >> 6), lane = tid & 63, wr = wid >> 2, wc = wid & 3, fr = lane & 15, fq = lane >> 4;
    const int K = g.K, nt = K / BK;
    unsigned voffA[2], voffB[2];
#pragma unroll
    for (int i = 0; i < 2; ++i) { int R, C; stage_rc(tid * 16 + i * 8192, R, C); const int Rb = Epi::PERM ? ((R & ~31) + perm32(R & 31)) : R;
        voffA[i] = (unsigned)(R * K + C) * 2u; voffB[i] = (unsigned)(Rb * K + C) * 2u; }
    const size_t kstep = (size_t)(BK * 2);
    const size_t hstep = (size_t)HALF * K * 2;
    const size_t tstep = 2 * hstep;
    const unsigned ldsw = (unsigned)wid * 1024u;
    const int aoff = lds_byte(wr * 64 + fr, fq * 8), boff = lds_byte(wc * 32 + fr, fq * 8);
#define PG8_SA(b, h) (((b) * 2 + (h)) * HTB)
#define PG8_SB(b, h) ((4 + (b) * 2 + (h)) * HTB)
#define PG8_STAGE(bufoff, gbase, voff) do { _Pragma("unroll") for (int _i = 0; _i < 2; ++_i) \
        __builtin_amdgcn_global_load_lds((const unsigned*)((const char*)(gbase) + (voff)[_i]), (PG8_LAS unsigned*)(lds + (bufoff) + ldsw + _i * 8192), 16, 0, 0); } while (0)
#define PG8_LDA(dst, b, h) do { _Pragma("unroll") for (int m = 0; m < 4; ++m) _Pragma("unroll") for (int k = 0; k < 2; ++k) dst[m][k] = *(const PG8_LAS bf16x8*)(lds + PG8_SA(b, h) + aoff + m * 2048 + k * 1024); } while (0)
#define PG8_LDB(dst, b, h) do { _Pragma("unroll") for (int n = 0; n < 2; ++n) _Pragma("unroll") for (int k = 0; k < 2; ++k) dst[n][k] = *(const PG8_LAS bf16x8*)(lds + PG8_SB(b, h) + boff + n * 2048 + k * 1024); } while (0)
#define PG8_MMA(ai, bj, At, Bt) do { __builtin_amdgcn_s_setprio(1); _Pragma("unroll") for (int m = 0; m < 4; ++m) _Pragma("unroll") for (int n = 0; n < 2; ++n) _Pragma("unroll") for (int k = 0; k < 2; ++k) \
        acc[ai][bj][m][n] = __builtin_amdgcn_mfma_f32_16x16x32_bf16(Bt[n][k], At[m][k], acc[ai][bj][m][n], 0, 0, 0); __builtin_amdgcn_s_setprio(0); } while (0)
#define PG8_WAIT_V(n) asm volatile("s_waitcnt vmcnt(" #n ")" ::: "memory")
#define PG8_WAIT_L(n) asm volatile("s_waitcnt lgkmcnt(" #n ")" ::: "memory")
#define PG8_BAR __builtin_amdgcn_s_barrier()
#define PG8_SCHED __builtin_amdgcn_sched_barrier(0)
    Unit cur, nxt; int ui = 0;
    if (!S.next(0, cur)) return;
    f32x4 acc[2][2][4][2];
#pragma unroll
    for (int a = 0; a < 2; ++a)
#pragma unroll
        for (int b = 0; b < 2; ++b)
#pragma unroll
            for (int m = 0; m < 4; ++m)
#pragma unroll
                for (int n = 0; n < 2; ++n) acc[a][b][m][n] = (f32x4){0.f, 0.f, 0.f, 0.f};
    bf16x8 At[4][2], B0[2][2], B1[2][2];
    const char* cA = (const char*)g.A + (size_t)cur.pm * tstep; const char* cB = (const char*)g.Bt + (size_t)cur.pn * tstep;
    S.a_ready(cur);
    if constexpr (SP2) {
        PG8_STAGE(PG8_SB(0, 0), cB, voffB); PG8_STAGE(PG8_SB(0, 1), cB + hstep, voffB); PG8_STAGE(PG8_SA(0, 0), cA, voffA); PG8_STAGE(PG8_SA(0, 1), cA + hstep, voffA);
        if (wr == 1) PG8_BAR;
        PG8_WAIT_V(2); PG8_BAR;
        PG8_STAGE(PG8_SB(1, 0), cB + kstep, voffB); PG8_STAGE(PG8_SA(1, 0), cA + kstep, voffA); PG8_STAGE(PG8_SB(1, 1), cB + hstep + kstep, voffB);
        PG8_WAIT_V(6); PG8_BAR;
    } else {
        PG8_STAGE(PG8_SB(0, 0), cB, voffB); PG8_STAGE(PG8_SA(0, 0), cA, voffA); PG8_STAGE(PG8_SB(0, 1), cB + hstep, voffB); PG8_STAGE(PG8_SA(0, 1), cA + hstep, voffA);
        if (wr == 1) PG8_BAR;
        PG8_WAIT_V(4); PG8_BAR;
        PG8_STAGE(PG8_SB(1, 0), cB + kstep, voffB); PG8_STAGE(PG8_SA(1, 0), cA + kstep, voffA); PG8_STAGE(PG8_SB(1, 1), cB + hstep + kstep, voffB);
        PG8_WAIT_V(6); PG8_BAR;
    }
    for (;;) {
        const bool has_next = S.next(ui + 1, nxt);
        const char* nA = has_next ? (const char*)g.A + (size_t)nxt.pm * tstep : cA; const char* nB = has_next ? (const char*)g.Bt + (size_t)nxt.pn * tstep : cB;
        for (int t = 0; t < nt; t += 2) {
            const bool last = (t == nt - 2);
            const char* a1 = cA + (size_t)(t + 1) * kstep;
            const char* a2 = last ? nA : cA + (size_t)(t + 2) * kstep; const char* b2 = last ? nB : cB + (size_t)(t + 2) * kstep;
            const char* a3 = a2 + kstep; const char* b3 = b2 + kstep;
            if (last && has_next) S.a_ready(nxt);
            if constexpr (SP2) {
            PG8_LDB(B0, 0, 0); PG8_LDB(B1, 0, 1); PG8_SCHED; PG8_LDA(At, 0, 0); PG8_STAGE(PG8_SA(1, 1), a1 + hstep, voffA);
            PG8_WAIT_V(8); PG8_WAIT_L(0); PG8_BAR; PG8_MMA(0, 0, At, B0); PG8_MMA(0, 1, At, B1); PG8_BAR; PG8_SCHED;
            PG8_LDA(At, 0, 1); PG8_STAGE(PG8_SB(0, 0), b2, voffB); PG8_STAGE(PG8_SB(0, 1), b2 + hstep, voffB); PG8_STAGE(PG8_SA(0, 0), a2, voffA);
            PG8_WAIT_V(8); PG8_WAIT_L(0); PG8_BAR; PG8_MMA(1, 0, At, B0); PG8_MMA(1, 1, At, B1); PG8_BAR; PG8_SCHED;
            PG8_LDB(B0, 1, 0); PG8_LDB(B1, 1, 1); PG8_SCHED; PG8_LDA(At, 1, 0); PG8_STAGE(PG8_SA(0, 1), a2 + hstep, voffA);
            PG8_WAIT_V(8); PG8_WAIT_L(0); PG8_BAR; PG8_MMA(0, 0, At, B0); PG8_MMA(0, 1, At, B1); PG8_BAR; PG8_SCHED;
            PG8_LDA(At, 1, 1); PG8_STAGE(PG8_SB(1, 0), b3, voffB); PG8_STAGE(PG8_SB(1, 1), b3 + hstep, voffB); PG8_STAGE(PG8_SA(1, 0), a3, voffA);
            PG8_WAIT_V(8); PG8_WAIT_L(0); PG8_BAR; PG8_MMA(1, 0, At, B0); PG8_MMA(1, 1, At, B1); PG8_BAR; PG8_SCHED;
            } else {
            PG8_LDB(B0, 0, 0); PG8_SCHED; PG8_LDA(At, 0, 0); PG8_STAGE(PG8_SA(1, 1), a1 + hstep, voffA);
            PG8_WAIT_L(8); PG8_BAR; PG8_WAIT_L(0); PG8_MMA(0, 0, At, B0); PG8_BAR; PG8_SCHED;
            PG8_LDB(B1, 0, 1); PG8_STAGE(PG8_SB(0, 0), b2, voffB);
            PG8_BAR; PG8_WAIT_L(0); PG8_MMA(0, 1, At, B1); PG8_BAR;
            PG8_LDA(At, 0, 1); PG8_STAGE(PG8_SA(0, 0), a2, voffA);
            PG8_BAR; PG8_WAIT_L(0); PG8_MMA(1, 0, At, B0); PG8_BAR; PG8_SCHED;
            PG8_STAGE(PG8_SB(0, 1), b2 + hstep, voffB);
            PG8_WAIT_V(6); PG8_BAR; PG8_MMA(1, 1, At, B1); PG8_BAR;
            PG8_LDB(B0, 1, 0); PG8_SCHED; PG8_LDA(At, 1, 0); PG8_STAGE(PG8_SA(0, 1), a2 + hstep, voffA);
            PG8_WAIT_L(8); PG8_BAR; PG8_WAIT_L(0); PG8_MMA(0, 0, At, B0); PG8_BAR; PG8_SCHED;
            PG8_LDB(B1, 1, 1); PG8_STAGE(PG8_SB(1, 0), b3, voffB);
            PG8_BAR; PG8_WAIT_L(0); PG8_MMA(0, 1, At, B1); PG8_BAR;
            PG8_LDA(At, 1, 1); PG8_STAGE(PG8_SA(1, 0), a3, voffA);
            PG8_BAR; PG8_WAIT_L(0); PG8_MMA(1, 0, At, B0); PG8_BAR; PG8_SCHED;
            PG8_STAGE(PG8_SB(1, 1), b3 + hstep, voffB);
            PG8_WAIT_V(6); PG8_BAR; PG8_MMA(1, 1, At, B1); PG8_BAR;
            }
        }
        if constexpr (ALIGN_EPI) { if (wr == 0) PG8_BAR; }
        if constexpr (!Epi::AFTER_DRAIN) { E(acc, cur, wr, wc, fr, fq); S.done(cur); }
        if (!has_next) break;
#pragma unroll
        for (int a = 0; a < 2; ++a)
#pragma unroll
            for (int b = 0; b < 2; ++b)
#pragma unroll
                for (int m = 0; m < 4; ++m)
#pragma unroll
                    for (int n = 0; n < 2; ++n) acc[a][b][m][n] = (f32x4){0.f, 0.f, 0.f, 0.f};
        cur = nxt; cA = nA; cB = nB; ++ui;
        if constexpr (ALIGN_EPI) { if (wr == 1) PG8_BAR; }
    }
    PG8_WAIT_V(0);
    if constexpr (!ALIGN_EPI) { if (wr == 0) PG8_BAR; }
    PG8_BAR;
    if constexpr (Epi::AFTER_DRAIN) { E.fused(acc, cur, wr, wc, fr, fq, lds, wid, lane); S.done(cur); }
#undef PG8_SA
#undef PG8_SB
#undef PG8_STAGE
#undef PG8_LDA
#undef PG8_LDB
#undef PG8_MMA
#undef PG8_WAIT_V
#undef PG8_WAIT_L
#undef PG8_BAR
#undef PG8_SCHED
}
}

typedef unsigned short bf16;
typedef short bf16x8 __attribute__((ext_vector_type(8)));
typedef float f32x4 __attribute__((ext_vector_type(4)));
typedef unsigned u32x4 __attribute__((ext_vector_type(4)));
typedef unsigned u32x2 __attribute__((ext_vector_type(2)));
typedef float f32x2_t __attribute__((ext_vector_type(2)));
typedef __bf16 bf16x2_t __attribute__((ext_vector_type(2)));
#define DI __device__ __forceinline__
#define LAS __attribute__((address_space(3)))

constexpr int DM = 1024, MTOK = 17408, MP = 16384, DIN = 2304, DFF = 2816, NL = 4, ZS = DIN;
constexpr int C_AX = 0, C_AG = 256, C_BQ = 512, C_BK = 768, C_BV = 1024, C_BG = 1280, C_CQ = 1536, C_CK = 2048, C_CV = 2176;
constexpr int NCT = 288;
constexpr float LN_EPS = 1e-5f;
constexpr float ALPHA = 1.681792830507429f;
constexpr int LDS_BYTES = 147456;
enum { I_XP = 0, I_XS, I_SCONV, I_SLRU, I_SRET, I_CK, I_CV, I_LNG, I_LNB, I_WIN, I_CONVW, I_CONVB, I_WRA, I_BRA, I_WRX, I_BRX, I_LAM, I_GNG, I_GNB, I_SINK, I_WOUT,
       I_LN1G, I_LN1B, I_WG, I_WU, I_WD, I_LN2G, I_LN2B, N_IN };
constexpr size_t O_Y = 0, O_PCONV = 17825792, O_PLRU = 17831936, O_PRET = 17833984, O_PK = 17965056, O_PV = 18096128, O_SCONV = 18227200, O_SLRU = 18325504,
                 O_SRET = 18358272, O_SK = 20455424, O_SV = 20979712, O_END = 21504000;
constexpr size_t WL_IN = 0, WL_OUT = 4718592, WL_GU = 6815744, WL_D = 18350080, WL_BYTES = 24117248;
constexpr size_t WS_W = 0, WS_OHB = 96468992, WS_Z = 132120576, WS_HLOC = 212336640, WS_PC = 230162432, WS_U = 247988224, WS_AS = 266862592, WS_BS = 267157504, WS_CTL = 267452416, CTL_BYTES = 16384, WS_END = WS_CTL + CTL_BYTES;
constexpr size_t WS_G = WS_Z;

struct KArgs { const float* in[N_IN]; float* out; unsigned char* ws; };

DI int otid() { int t = threadIdx.x; asm volatile("" : "+v"(t)); return t; }
constexpr int MISC_OFF = 131072 + 512;
constexpr int TBL_OFF = 131072 + 1024;
DI const float* inp_(const unsigned char* lds, int i) {
    const LAS unsigned* t = (const LAS unsigned*)((const LAS unsigned char*)lds + TBL_OFF) + 2 * i;
    const unsigned lo = __builtin_amdgcn_readfirstlane(t[0]), hi = __builtin_amdgcn_readfirstlane(t[1]);
    return (const float*)(((unsigned long long)hi << 32) | (unsigned long long)lo);
}
#define INP(i) inp_(lds, (i))
DI float bf2f(bf16 v) { return __uint_as_float((unsigned)v << 16); }
DI unsigned pk2(float lo, float hi) { f32x2_t v = {lo, hi}; bf16x2_t b = __builtin_convertvector(v, bf16x2_t); return __builtin_bit_cast(unsigned, b); }
DI bf16x8 pack8(f32x4 a, f32x4 b) { u32x4 p; p.x = pk2(a[0], a[1]); p.y = pk2(a[2], a[3]); p.z = pk2(b[0], b[1]); p.w = pk2(b[2], b[3]); return __builtin_bit_cast(bf16x8, p); }
DI float sigmoidf_(float x) { return 1.0f / (1.0f + __expf(-x)); }
DI float gelu_tanh(float x) { const float y = 0.7978845608028654f * (x + 0.044715f * x * x * x); const float t = 1.0f - 2.0f / (__expf(2.0f * y) + 1.0f); return 0.5f * x * (1.0f + t); }
DI float wave_sum(float v) {
#pragma unroll
    for (int o = 1; o < 64; o <<= 1) v += __shfl_xor(v, o);
    return v;
}
#define MFMA16(a, b, c) __builtin_amdgcn_mfma_f32_16x16x32_bf16((a), (b), (c), 0, 0, 0)

DI void p0_transpose_item(const float* W, int K, int N, bf16* WT, int mode, LAS float* scr, int item, int lane) {
    const int nblk = N / 32, kb = item / nblk, nb = item % nblk, k0 = 64 * kb, n0 = 32 * nb;
#pragma unroll 8
    for (int i = 0; i < 32; ++i) { const int kk = 2 * i + (lane >> 5); scr[kk * 33 + (lane & 31)] = W[(size_t)(k0 + kk) * N + n0 + (lane & 31)]; }
    asm volatile("s_waitcnt lgkmcnt(0)" ::: "memory");
    const int c = lane & 7;
#pragma unroll
    for (int j = 0; j < 4; ++j) { const int n = (lane >> 3) + 8 * j; const LAS float* s = scr + (8 * c) * 33 + n;
        u32x4 o; o.x = pk2(s[0 * 33], s[1 * 33]); o.y = pk2(s[2 * 33], s[3 * 33]); o.z = pk2(s[4 * 33], s[5 * 33]); o.w = pk2(s[6 * 33], s[7 * 33]);
        const int ng = n0 + n; const int row = mode == 0 ? ng : ((ng >> 2) * 8 + (ng & 3) + (mode == 2 ? 4 : 0));
        *(u32x4*)(WT + (size_t)row * K + k0 + 8 * c) = o; }
    asm volatile("s_waitcnt lgkmcnt(0)" ::: "memory");
}
DI void ln_row(const float* xrow, const float* g, const float* b, float* hrow, bf16* hbrow, int lane) {
    const f32x4* xr = (const f32x4*)xrow + lane;
    f32x4 v[4]; float s = 0.f;
#pragma unroll
    for (int j = 0; j < 4; ++j) { v[j] = xr[64 * j]; s += (v[j].x + v[j].y) + (v[j].z + v[j].w); }
    const float mean = wave_sum(s) * (1.f / DM); float s2 = 0.f;
#pragma unroll
    for (int j = 0; j < 4; ++j) { v[j] = v[j] - mean; s2 += (v[j].x * v[j].x + v[j].y * v[j].y) + (v[j].z * v[j].z + v[j].w * v[j].w); }
    const float rstd = 1.f / sqrtf(wave_sum(s2) * (1.f / DM) + LN_EPS);
#pragma unroll
    for (int j = 0; j < 4; ++j) { const f32x4 gg = ((const f32x4*)g)[lane + 64 * j], bb = ((const f32x4*)b)[lane + 64 * j];
        const f32x4 y = v[j] * rstd * gg + bb; ((f32x4*)hrow)[lane + 64 * j] = y;
        if (hbrow) { u32x2 w; w.x = pk2(y.x, y.y); w.y = pk2(y.z, y.w); ((u32x2*)hbrow)[lane + 64 * j] = w; } }
}
DI void phase_p0(const KArgs& a, unsigned char* lds, int wave, int lane) {
    LAS float* scr = (LAS float*)((LAS unsigned char*)lds + wave * 16384);
    const int gw = blockIdx.x * 8 + wave, NGW = gridDim.x * 8;
    constexpr int I_IN = 16 * 72, I_OUT = 16 * 32, I_GT = 16 * 88, I_DN = 44 * 32, I_LAYER = I_IN + I_OUT + 2 * I_GT + I_DN;
    for (int it = gw; it < NL * I_LAYER; it += NGW) {
        const int l = it / I_LAYER; int r = it % I_LAYER; unsigned char* wl = a.ws + WS_W + (size_t)l * WL_BYTES;
        if (r < I_IN) { p0_transpose_item(INP(I_WIN) + (size_t)l * DM * DIN, DM, DIN, (bf16*)(wl + WL_IN), 0, scr, r, lane); continue; } r -= I_IN;
        if (r < I_OUT) { p0_transpose_item(INP(I_WOUT) + (size_t)l * DM * DM, DM, DM, (bf16*)(wl + WL_OUT), 0, scr, r, lane); continue; } r -= I_OUT;
        if (r < I_GT) { p0_transpose_item(INP(I_WG) + (size_t)l * DM * DFF, DM, DFF, (bf16*)(wl + WL_GU), 1, scr, r, lane); continue; } r -= I_GT;
        if (r < I_GT) { p0_transpose_item(INP(I_WU) + (size_t)l * DM * DFF, DM, DFF, (bf16*)(wl + WL_GU), 2, scr, r, lane); continue; } r -= I_GT;
        p0_transpose_item(INP(I_WD) + (size_t)l * DFF * DM, DFF, DM, (bf16*)(wl + WL_D), 0, scr, r, lane);
    }
    float* h = a.out + O_Y; bf16* hb = (bf16*)(a.ws + WS_OHB);
    for (int m = gw; m < MTOK; m += NGW) {
        const float* xrow = m < MP ? INP(I_XP) + (size_t)m * DM : INP(I_XS) + (size_t)(m - MP) * DM;
        ln_row(xrow, INP(I_LNG), INP(I_LNB), h + (size_t)m * DM, hb + (size_t)m * DM, lane);
    }
}
DI void phase_ln(const KArgs& a, const float* g, const float* b, bool want_bf16, int wave, int lane) {
    const int gw = blockIdx.x * 8 + wave, NGW = gridDim.x * 8;
    float* h = a.out + O_Y; bf16* hb = (bf16*)(a.ws + WS_OHB);
    f32x4 gg[4], bb[4];
#pragma unroll
    for (int j = 0; j < 4; ++j) { gg[j] = ((const f32x4*)g)[lane + 64 * j]; bb[j] = ((const f32x4*)b)[lane + 64 * j]; }
    for (int m = gw; m < MTOK; m += 2 * NGW) {
        const int m1 = m + NGW; const bool two = m1 < MTOK;
        f32x4 v0[4], v1[4]; float s0 = 0.f, s1 = 0.f;
        const f32x4* x0 = (const f32x4*)(h + (size_t)m * DM) + lane; const f32x4* x1 = (const f32x4*)(h + (size_t)(two ? m1 : m) * DM) + lane;
#pragma unroll
        for (int j = 0; j < 4; ++j) { v0[j] = x0[64 * j]; v1[j] = x1[64 * j]; }
#pragma unroll
        for (int j = 0; j < 4; ++j) { s0 += (v0[j].x + v0[j].y) + (v0[j].z + v0[j].w); s1 += (v1[j].x + v1[j].y) + (v1[j].z + v1[j].w); }
        const float mean0 = wave_sum(s0) * (1.f / DM), mean1 = wave_sum(s1) * (1.f / DM); float q0 = 0.f, q1 = 0.f;
#pragma unroll
        for (int j = 0; j < 4; ++j) { v0[j] = v0[j] - mean0; v1[j] = v1[j] - mean1;
            q0 += (v0[j].x * v0[j].x + v0[j].y * v0[j].y) + (v0[j].z * v0[j].z + v0[j].w * v0[j].w); q1 += (v1[j].x * v1[j].x + v1[j].y * v1[j].y) + (v1[j].z * v1[j].z + v1[j].w * v1[j].w); }
        const float r0 = 1.f / sqrtf(wave_sum(q0) * (1.f / DM) + LN_EPS), r1 = 1.f / sqrtf(wave_sum(q1) * (1.f / DM) + LN_EPS);
#pragma unroll
        for (int j = 0; j < 4; ++j) { const f32x4 y = v0[j] * r0 * gg[j] + bb[j]; ((f32x4*)(h + (size_t)m * DM))[lane + 64 * j] = y;
            if (want_bf16) { u32x2 w; w.x = pk2(y.x, y.y); w.y = pk2(y.z, y.w); ((u32x2*)(hb + (size_t)m * DM))[lane + 64 * j] = w; } }
        if (two) {
#pragma unroll
            for (int j = 0; j < 4; ++j) { const f32x4 y = v1[j] * r1 * gg[j] + bb[j]; ((f32x4*)(h + (size_t)m1 * DM))[lane + 64 * j] = y;
                if (want_bf16) { u32x2 w; w.x = pk2(y.x, y.y); w.y = pk2(y.z, y.w); ((u32x2*)(hb + (size_t)m1 * DM))[lane + 64 * j] = w; } } }
    }
}

struct CT { int row0, L, b, n, sb; bool sample; };
DI CT ct_decode(int ct) { CT c; if (ct < 256) { c.sample = false; c.b = ct >> 7; c.n = ct & 127; c.sb = 0; c.row0 = c.b * 8192 + c.n * 64; c.L = 64; }
                          else { c.sample = true; c.sb = ct - 256; c.b = 0; c.n = 0; c.row0 = MP + c.sb * 32; c.L = 32; } return c; }
DI float lg2_gamma(int h) { return __log2f(1.0f - exp2f(-5.0f - (float)h)); }

DI void m1_a_item(const KArgs& a, int l, int ct, unsigned char* lds) {
    const int tid = otid(), c = tid & 255, half = tid >> 8, t0 = half * 32;
    const CT k = ct_decode(ct);
    float* us = (float*)lds;
    float* ex = us + 64 * 256;
    const bf16* z = (const bf16*)(a.ws + WS_Z);
    const bf16* zc = z + (size_t)k.row0 * ZS + C_AX + c;
    const bool active = t0 < k.L;
    const float* cw = INP(I_CONVW) + (size_t)l * 4 * 256 + c;
    const float cw0 = cw[0], cw1 = cw[256], cw2 = cw[512], cw3 = cw[768], cb = INP(I_CONVB)[l * 256 + c];
    float x0 = 0.f, x1 = 0.f, x2 = 0.f;
    if (active) {
        if (t0 == 0) {
            if (!k.sample) { if (k.n != 0) { x0 = bf2f(zc[-3 * ZS]); x1 = bf2f(zc[-2 * ZS]); x2 = bf2f(zc[-1 * ZS]); } }
            else { const float* sc = INP(I_SCONV) + ((size_t)(l * 32 + k.sb) * 3) * 256 + c; x0 = sc[0]; x1 = sc[256]; x2 = sc[512]; }
        } else { x0 = bf2f(zc[(t0 - 3) * ZS]); x1 = bf2f(zc[(t0 - 2) * ZS]); x2 = bf2f(zc[(t0 - 1) * ZS]); }
#pragma unroll 8
        for (int t = 0; t < 32; ++t) { const float x3 = bf2f(zc[(size_t)(t0 + t) * ZS]); us[(t0 + t) * 256 + c] = cb + cw0 * x0 + cw1 * x1 + cw2 * x2 + cw3 * x3; x0 = x1; x1 = x2; x2 = x3; }
        if (!k.sample && k.n == 127 && half == 1) { float* o = a.out + O_PCONV + ((size_t)(l * 2 + k.b) * 3) * 256 + c; o[0] = x0; o[256] = x1; o[512] = x2; }
        if (k.sample) { float* o = a.out + O_SCONV + ((size_t)(l * 32 + k.sb) * 3) * 256 + c; o[0] = x0; o[256] = x1; o[512] = x2; }
    }
    __syncthreads();
    float ar[32], ax[32];
#pragma unroll
    for (int t = 0; t < 32; ++t) { ar[t] = 0.f; ax[t] = 0.f; }
    if (active) {
        const int hh = c >> 6, j = c & 63;
        const float* Wa = INP(I_WRA) + ((size_t)(l * 4 + hh) * 64) * 64 + j;
        const float* Wx = INP(I_WRX) + ((size_t)(l * 4 + hh) * 64) * 64 + j;
#pragma unroll 1
        for (int i = 0; i < 64; i += 4) {
            const float wa0 = Wa[(i + 0) * 64], wa1 = Wa[(i + 1) * 64], wa2 = Wa[(i + 2) * 64], wa3 = Wa[(i + 3) * 64];
            const float wx0 = Wx[(i + 0) * 64], wx1 = Wx[(i + 1) * 64], wx2 = Wx[(i + 2) * 64], wx3 = Wx[(i + 3) * 64];
#pragma unroll
            for (int t = 0; t < 32; ++t) { const f32x4 u4 = *(const f32x4*)&us[(t0 + t) * 256 + hh * 64 + i];
                ar[t] += u4.x * wa0 + u4.y * wa1 + u4.z * wa2 + u4.w * wa3; ax[t] += u4.x * wx0 + u4.y * wx1 + u4.z * wx2 + u4.w * wx3;
                if ((t & 7) == 7) __builtin_amdgcn_sched_barrier(0); }
        }
        const float ba = INP(I_BRA)[l * 256 + c], bx = INP(I_BRX)[l * 256 + c];
        const float sp = log1pf(expf(-INP(I_LAM)[l * 256 + c]));
        float P = 1.f, hl = 0.f;
#pragma unroll
        for (int t = 0; t < 32; ++t) { const float r = sigmoidf_(ar[t] + ba), gi = sigmoidf_(ax[t] + bx); const float la = -8.0f * r * sp; const float av = expf(la);
            const float bt = sqrtf(fmaxf(-expm1f(2.0f * la), 0.f)) * gi * us[(t0 + t) * 256 + c]; hl = av * hl + bt; P *= av; ar[t] = P; ax[t] = hl; }
        if (half == 0) { ex[c] = P; ex[256 + c] = hl; }
    }
    __syncthreads();
    if (active) {
        if (half == 1) { const float P0 = ex[c], h0 = ex[256 + c];
#pragma unroll
            for (int t = 0; t < 32; ++t) { ax[t] += ar[t] * h0; ar[t] *= P0; } }
        float* hloc = (float*)(a.ws + WS_HLOC) + (size_t)(k.row0 + t0) * 256 + c; float* pc = (float*)(a.ws + WS_PC) + (size_t)(k.row0 + t0) * 256 + c;
#pragma unroll
        for (int t = 0; t < 32; ++t) { hloc[t * 256] = ax[t]; pc[t * 256] = ar[t]; }
        float* As = (float*)(a.ws + WS_AS) + ct * 256 + c; float* Bs = (float*)(a.ws + WS_BS) + ct * 256 + c;
        if (!k.sample && half == 1) { *As = ar[31]; *Bs = ax[31]; }
        if (k.sample) { const float h0s = INP(I_SLRU)[(size_t)(l * 32 + k.sb) * 256 + c]; a.out[O_SLRU + (size_t)(l * 32 + k.sb) * 256 + c] = ar[31] * h0s + ax[31]; *As = ar[31]; *Bs = h0s; }
    }
    __syncthreads();
}

DI void m1_u_item(const KArgs& a, int l, int ct, unsigned char* lds) {
    const int tid = otid(), lane = tid & 63, w = tid >> 6;
    const CT k = ct_decode(ct);
    float* kw = (float*)lds;
    float* vv = kw + 4 * 64 * 64;
    const bf16* z = (const bf16*)(a.ws + WS_Z);
    { const int cp = tid & 127, js = tid >> 7, hh = cp >> 5, d = 2 * (cp & 31); const float lg = lg2_gamma(hh);
      for (int j = js; j < k.L; j += 4) {
          const bf16* zr = z + (size_t)(k.row0 + j) * ZS;
          const unsigned kk = *(const unsigned*)(zr + C_BK + 2 * cp), vx = *(const unsigned*)(zr + C_BV + 2 * cp);
          const float wj = exp2f((float)(k.L - 1 - j) * lg) * 0.125f;
          kw[(hh * 64 + j) * 64 + d] = __uint_as_float(kk << 16) * wj; kw[(hh * 64 + j) * 64 + d + 1] = __uint_as_float(kk & 0xffff0000u) * wj;
          vv[(hh * 64 + j) * 64 + d] = __uint_as_float(vx << 16); vv[(hh * 64 + j) * 64 + d + 1] = __uint_as_float(vx & 0xffff0000u); } }
    __syncthreads();
    const int hh = w >> 1, dh = (w & 1) * 32;
    float acc[32];
#pragma unroll
    for (int i = 0; i < 32; ++i) acc[i] = 0.f;
#pragma unroll 2
    for (int j = 0; j < k.L; ++j) { const float ve = vv[(hh * 64 + j) * 64 + lane];
#pragma unroll
        for (int dd = 0; dd < 32; dd += 4) { const f32x4 k4 = *(const f32x4*)&kw[(hh * 64 + j) * 64 + dh + dd]; acc[dd] += k4.x * ve; acc[dd + 1] += k4.y * ve; acc[dd + 2] += k4.z * ve; acc[dd + 3] += k4.w * ve; } }
    if (!k.sample) { float* U = (float*)(a.ws + WS_U) + ((size_t)(ct * 4 + hh) * 64 + dh) * 64 + lane;
#pragma unroll
        for (int dd = 0; dd < 32; ++dd) U[dd * 64] = acc[dd]; }
    else { const size_t base = (((size_t)(l * 32 + k.sb) * 4 + hh) * 64 + dh) * 64 + lane; const float g32 = exp2f(32.0f * lg2_gamma(hh));
        const float* s0 = INP(I_SRET) + base; float* o = a.out + O_SRET + base;
#pragma unroll
        for (int dd = 0; dd < 32; ++dd) o[dd * 64] = g32 * s0[dd * 64] + acc[dd]; }
    __syncthreads();
}

constexpr int VS = 200;
template <bool SAMPLE> DI void m1_swa_item(const KArgs& a, int l, int ct, int kh, unsigned char* lds) {
    constexpr int NQT = SAMPLE ? 1 : 2, NKT = SAMPLE ? 10 : 12, NK = NKT * 16;
    const int tid = otid(), lane = tid & 63, w = tid >> 6, fr = lane & 15, fq = lane >> 4;
    const CT k = ct_decode(ct);
    bf16* VT = (bf16*)lds;
    const bf16* z = (const bf16*)(a.ws + WS_Z);
    const int seq0 = k.n * 64 - 128;
    for (int p = tid; p < NK * 8; p += 512) {
        const int key = p >> 3, d0 = (p & 7) * 8; u32x4 raw = (u32x4){0u, 0u, 0u, 0u};
        if constexpr (!SAMPLE) { if (seq0 + key >= 0) raw = *(const u32x4*)(z + (size_t)(k.b * 8192 + seq0 + key) * ZS + C_CV + kh * 64 + d0); }
        else { if (key < 128) { const float* cv = INP(I_CV) + (((size_t)(l * 32 + k.sb) * 128 + key) * 2 + kh) * 64 + d0; const f32x4 f0 = *(const f32x4*)cv, f1 = *(const f32x4*)(cv + 4);
                   raw.x = pk2(f0.x, f0.y); raw.y = pk2(f0.z, f0.w); raw.z = pk2(f1.x, f1.y); raw.w = pk2(f1.z, f1.w); }
               else raw = *(const u32x4*)(z + (size_t)(k.row0 + key - 128) * ZS + C_CV + kh * 64 + d0); }
        bf16* dst = VT + (size_t)d0 * VS + key;
        dst[0 * VS] = (bf16)(raw.x & 0xffffu); dst[1 * VS] = (bf16)(raw.x >> 16); dst[2 * VS] = (bf16)(raw.y & 0xffffu); dst[3 * VS] = (bf16)(raw.y >> 16);
        dst[4 * VS] = (bf16)(raw.z & 0xffffu); dst[5 * VS] = (bf16)(raw.z >> 16); dst[6 * VS] = (bf16)(raw.w & 0xffffu); dst[7 * VS] = (bf16)(raw.w >> 16);
    }
    __syncthreads();
    const int g = w >> 1, qbase = (w & 1) * (NQT * 16), hd = kh * 4 + g;
    const float slope = exp2f(-(float)(hd + 1)), sink = INP(I_SINK)[l * 8 + hd];
    bf16x8 qf[NQT][2];
#pragma unroll
    for (int qt = 0; qt < NQT; ++qt)
#pragma unroll
        for (int kk = 0; kk < 2; ++kk) qf[qt][kk] = *(const bf16x8*)(z + (size_t)(k.row0 + qbase + qt * 16 + fr) * ZS + C_CQ + hd * 64 + kk * 32 + fq * 8);
    f32x4 S[NQT][NKT];
#pragma unroll
    for (int kt = 0; kt < NKT; ++kt) {
        const int key = kt * 16 + fr; bf16x8 kf[2];
        if constexpr (!SAMPLE) { const int sp = seq0 + key; const bf16* kr = z + (size_t)(k.b * 8192 + (sp < 0 ? 0 : sp)) * ZS + C_CK + kh * 64 + fq * 8;
            kf[0] = *(const bf16x8*)kr; kf[1] = *(const bf16x8*)(kr + 32); }
        else { if (kt < 8) { const float* ck = INP(I_CK) + (((size_t)(l * 32 + k.sb) * 128 + key) * 2 + kh) * 64 + fq * 8;
                   kf[0] = pack8(*(const f32x4*)ck, *(const f32x4*)(ck + 4)); kf[1] = pack8(*(const f32x4*)(ck + 32), *(const f32x4*)(ck + 36)); }
               else { const bf16* kr = z + (size_t)(k.row0 + key - 128) * ZS + C_CK + kh * 64 + fq * 8; kf[0] = *(const bf16x8*)kr; kf[1] = *(const bf16x8*)(kr + 32); } }
#pragma unroll
        for (int qt = 0; qt < NQT; ++qt) { f32x4 s = (f32x4){0.f, 0.f, 0.f, 0.f}; s = MFMA16(kf[0], qf[qt][0], s); s = MFMA16(kf[1], qf[qt][1], s); S[qt][kt] = s; }
    }
    bf16x8 pf[NQT][NKT / 2];
#pragma unroll
    for (int qt = 0; qt < NQT; ++qt) {
        const int qi = qbase + qt * 16 + fr; float m = -3.0e38f;
#pragma unroll
        for (int kt = 0; kt < NKT; ++kt)
#pragma unroll
            for (int jj = 0; jj < 4; ++jj) { const int key = kt * 16 + fq * 4 + jj; const float dist = fabsf((float)(128 + qi - key)); float s = S[qt][kt][jj] * 0.125f - slope * dist;
                if constexpr (!SAMPLE) { if (seq0 + key < 0) s = -1e30f; }
                S[qt][kt][jj] = s; m = fmaxf(m, s); }
        m = fmaxf(m, __shfl_xor(m, 16)); m = fmaxf(m, __shfl_xor(m, 32)); m = fmaxf(m, sink);
        float sum = 0.f;
#pragma unroll
        for (int kt = 0; kt < NKT; ++kt)
#pragma unroll
            for (int jj = 0; jj < 4; ++jj) { const float e = __expf(S[qt][kt][jj] - m); S[qt][kt][jj] = e; sum += e; }
        sum += __shfl_xor(sum, 16); sum += __shfl_xor(sum, 32);
        const float inv = 1.0f / (sum + __expf(sink - m));
#pragma unroll
        for (int kb = 0; kb < NKT / 2; ++kb) pf[qt][kb] = pack8(S[qt][2 * kb] * inv, S[qt][2 * kb + 1] * inv);
    }
    bf16* ob = (bf16*)(a.ws + WS_OHB);
#pragma unroll
    for (int dt = 0; dt < 4; ++dt) {
        f32x4 o[NQT];
#pragma unroll
        for (int qt = 0; qt < NQT; ++qt) o[qt] = (f32x4){0.f, 0.f, 0.f, 0.f};
#pragma unroll
        for (int kb = 0; kb < NKT / 2; ++kb) {
            const bf16* vp = VT + (size_t)(dt * 16 + fr) * VS + kb * 32 + fq * 4;
            u32x4 vr; const u32x2 v0 = *(const u32x2*)vp, v1 = *(const u32x2*)(vp + 16); vr.x = v0.x; vr.y = v0.y; vr.z = v1.x; vr.w = v1.y;
            const bf16x8 vf = __builtin_bit_cast(bf16x8, vr);
#pragma unroll
            for (int qt = 0; qt < NQT; ++qt) o[qt] = MFMA16(vf, pf[qt][kb], o[qt]);
        }
#pragma unroll
        for (int qt = 0; qt < NQT; ++qt) { u32x2 wv; wv.x = pk2(o[qt][0], o[qt][1]); wv.y = pk2(o[qt][2], o[qt][3]);
            *(u32x2*)(ob + (size_t)(k.row0 + qbase + qt * 16 + fr) * DM + 512 + hd * 64 + dt * 16 + fq * 4) = wv; }
    }
    __syncthreads();
}

DI void phase_m1(const KArgs& a, int l, unsigned char* lds) {
    for (int it = blockIdx.x; it < 1152; it += gridDim.x) {
        if (it < 576) { const int ct = it >> 1, kh = it & 1; if (ct < 256) m1_swa_item<false>(a, l, ct, kh, lds); else m1_swa_item<true>(a, l, ct, kh, lds); }
        else if (it < 864) m1_a_item(a, l, it - 576, lds);
        else m1_u_item(a, l, it - 864, lds);
    }
}

DI void phase_m2(const KArgs& a, int l, unsigned char* lds) {
    const int tid = otid(), bx = blockIdx.x;
    if (bx == 0) {
        const int b = tid >> 8, c = tid & 255; float* As = (float*)(a.ws + WS_AS) + (size_t)(b * 128) * 256 + c; float* Bs = (float*)(a.ws + WS_BS) + (size_t)(b * 128) * 256 + c;
        float H = 0.f;
#pragma unroll 1
        for (int n = 0; n < 128; n += 8) { float av[8], bv[8];
#pragma unroll
            for (int i = 0; i < 8; ++i) { av[i] = As[(n + i) * 256]; bv[i] = Bs[(n + i) * 256]; }
#pragma unroll
            for (int i = 0; i < 8; ++i) { Bs[(n + i) * 256] = H; H = av[i] * H + bv[i]; } }
        a.out[O_PLRU + (size_t)(l * 2 + b) * 256 + c] = H;
    } else if (bx <= 64) {
        const int e = (bx - 1) * 512 + tid, b = e >> 14, rem = e & 16383, hh = rem >> 12, de = rem & 4095;
        const float g = exp2f(64.0f * lg2_gamma(hh));
        float* U = (float*)(a.ws + WS_U) + ((size_t)(b * 128) * 4 + hh) * 4096 + de; float s = 0.f;
#pragma unroll 1
        for (int n = 0; n < 128; n += 8) { float uv[8];
#pragma unroll
            for (int i = 0; i < 8; ++i) uv[i] = U[(size_t)(n + i) * 16384];
#pragma unroll
            for (int i = 0; i < 8; ++i) { U[(size_t)(n + i) * 16384] = s; s = g * s + uv[i]; } }
        a.out[O_PRET + ((size_t)(l * 2 + b) * 4 + hh) * 4096 + de] = s;
    } else {
        const bf16* z = (const bf16*)(a.ws + WS_Z);
        for (int i = (bx - 65) * 512 + tid; i < 1280 * 64; i += (gridDim.x - 65) * 512) {
            const int r = i >> 6, c4 = (i & 63) * 4; int zrow; float* ok;
            if (r < 256) { const int b = r >> 7, w = r & 127; zrow = b * 8192 + 8064 + w; ok = a.out + (c4 < 128 ? O_PK : O_PV) + ((size_t)(l * 2 + b) * 128 + w) * 128; }
            else { const int rs = r - 256; zrow = MP + rs; ok = a.out + (c4 < 128 ? O_SK : O_SV) + ((size_t)l * 1024 + rs) * 128; }
            const u32x2 raw = *(const u32x2*)(z + (size_t)zrow * ZS + C_CK + c4);
            f32x4 o; o.x = __uint_as_float(raw.x << 16); o.y = __uint_as_float(raw.x & 0xffff0000u); o.z = __uint_as_float(raw.y << 16); o.w = __uint_as_float(raw.y & 0xffff0000u);
            *(f32x4*)(ok + (c4 & 127)) = o;
        }
    }
}

constexpr int TS = 72;
template <bool SAMPLE> DI void m3_item(const KArgs& a, int l, int ct, unsigned char* lds) {
    constexpr int L = SAMPLE ? 32 : 64, NIT = SAMPLE ? 1 : 2, NJT = L / 16;
    const int tid = otid(), lane = tid & 63, w = tid >> 6, fr = lane & 15, fq = lane >> 4;
    const CT k = ct_decode(ct);
    const bf16* z = (const bf16*)(a.ws + WS_Z);
    bf16* ob = (bf16*)(a.ws + WS_OHB);
    bf16* VT = (bf16*)lds;
    bf16* ST = VT + 4 * 64 * TS;
    { const int c4 = (tid & 63) * 4; const f32x4 hin = *(const f32x4*)((const float*)(a.ws + WS_BS) + ct * 256 + c4);
      for (int t = tid >> 6; t < L; t += 8) { const size_t r = (size_t)(k.row0 + t);
          const f32x4 hl = *(const f32x4*)((const float*)(a.ws + WS_HLOC) + r * 256 + c4), pc = *(const f32x4*)((const float*)(a.ws + WS_PC) + r * 256 + c4);
          const u32x2 ag = *(const u32x2*)(z + r * ZS + C_AG + c4);
          const f32x4 hv = hl + pc * hin;
          u32x2 o; o.x = pk2(hv.x * gelu_tanh(__uint_as_float(ag.x << 16)), hv.y * gelu_tanh(__uint_as_float(ag.x & 0xffff0000u)));
          o.y = pk2(hv.z * gelu_tanh(__uint_as_float(ag.y << 16)), hv.w * gelu_tanh(__uint_as_float(ag.y & 0xffff0000u)));
          *(u32x2*)(ob + r * DM + c4) = o; } }
    for (int p = tid; p < L * 32; p += 512) { const int j = p >> 5, col = (p & 31) * 8;
        const u32x4 raw = *(const u32x4*)(z + (size_t)(k.row0 + j) * ZS + C_BV + col); bf16* dst = VT + (size_t)col * TS + j;
        dst[0 * TS] = (bf16)(raw.x & 0xffffu); dst[1 * TS] = (bf16)(raw.x >> 16); dst[2 * TS] = (bf16)(raw.y & 0xffffu); dst[3 * TS] = (bf16)(raw.y >> 16);
        dst[4 * TS] = (bf16)(raw.z & 0xffffu); dst[5 * TS] = (bf16)(raw.z >> 16); dst[6 * TS] = (bf16)(raw.w & 0xffffu); dst[7 * TS] = (bf16)(raw.w >> 16); }
    { const float* Sp = SAMPLE ? INP(I_SRET) + (size_t)(l * 32 + k.sb) * 16384 : (const float*)(a.ws + WS_U) + (size_t)ct * 16384;
      for (int p = tid; p < 4096; p += 512) { const int hh = p >> 10, d = (p >> 4) & 63, e0 = (p & 15) * 4; const f32x4 s = *(const f32x4*)(Sp + (size_t)(hh * 64 + d) * 64 + e0);
          bf16* dst = ST + (size_t)(hh * 64 + e0) * TS + d; const unsigned p0 = pk2(s.x, s.y), p1 = pk2(s.z, s.w);
          dst[0 * TS] = (bf16)(p0 & 0xffffu); dst[1 * TS] = (bf16)(p0 >> 16); dst[2 * TS] = (bf16)(p1 & 0xffffu); dst[3 * TS] = (bf16)(p1 >> 16); } }
    __syncthreads();
    const int hh = w >> 1, half = w & 1; const float lg = lg2_gamma(hh);
    bf16x8 qf[NIT][2];
#pragma unroll
    for (int it = 0; it < NIT; ++it)
#pragma unroll
        for (int kk = 0; kk < 2; ++kk) qf[it][kk] = *(const bf16x8*)(z + (size_t)(k.row0 + half * (NIT * 16) + it * 16 + fr) * ZS + C_BQ + hh * 64 + kk * 32 + fq * 8);
    bf16x8 pf[NIT][NJT / 2];
    {   f32x4 S[NIT][NJT];
#pragma unroll
        for (int jt = 0; jt < NJT; ++jt) { const bf16* kr = z + (size_t)(k.row0 + jt * 16 + fr) * ZS + C_BK + hh * 64 + fq * 8;
            const bf16x8 kf0 = *(const bf16x8*)kr, kf1 = *(const bf16x8*)(kr + 32);
#pragma unroll
            for (int it = 0; it < NIT; ++it) { f32x4 s = (f32x4){0.f, 0.f, 0.f, 0.f}; s = MFMA16(kf0, qf[it][0], s); s = MFMA16(kf1, qf[it][1], s);
                const int i = half * (NIT * 16) + it * 16 + fr;
#pragma unroll
                for (int jj = 0; jj < 4; ++jj) { const int dij = i - (jt * 16 + fq * 4 + jj); s[jj] = dij >= 0 ? s[jj] * 0.125f * exp2f((float)dij * lg) : 0.f; }
                S[it][jt] = s; } }
#pragma unroll
        for (int it = 0; it < NIT; ++it)
#pragma unroll
            for (int jb = 0; jb < NJT / 2; ++jb) pf[it][jb] = pack8(S[it][2 * jb], S[it][2 * jb + 1]);
    }
    f32x4 o[NIT][4];
#pragma unroll
    for (int et = 0; et < 4; ++et) {
        f32x4 oi[NIT], oc[NIT];
#pragma unroll
        for (int it = 0; it < NIT; ++it) { oi[it] = (f32x4){0.f, 0.f, 0.f, 0.f}; oc[it] = (f32x4){0.f, 0.f, 0.f, 0.f}; }
#pragma unroll
        for (int jb = 0; jb < NJT / 2; ++jb) { const bf16* vp = VT + (size_t)(hh * 64 + et * 16 + fr) * TS + jb * 32 + fq * 4;
            u32x4 vr; const u32x2 v0 = *(const u32x2*)vp, v1 = *(const u32x2*)(vp + 16); vr.x = v0.x; vr.y = v0.y; vr.z = v1.x; vr.w = v1.y; const bf16x8 vf = __builtin_bit_cast(bf16x8, vr);
#pragma unroll
            for (int it = 0; it < NIT; ++it) oi[it] = MFMA16(vf, pf[it][jb], oi[it]); }
#pragma unroll
        for (int kk = 0; kk < 2; ++kk) { const bf16x8 sf = *(const bf16x8*)(ST + (size_t)(hh * 64 + et * 16 + fr) * TS + kk * 32 + fq * 8);
#pragma unroll
            for (int it = 0; it < NIT; ++it) oc[it] = MFMA16(sf, qf[it][kk], oc[it]); }
#pragma unroll
        for (int it = 0; it < NIT; ++it) { const int i = half * (NIT * 16) + it * 16 + fr; o[it][et] = oi[it] + oc[it] * exp2f((float)(i + 1) * lg); }
    }
#pragma unroll
    for (int it = 0; it < NIT; ++it) {
        const int i = half * (NIT * 16) + it * 16 + fr; const size_t r = (size_t)(k.row0 + i);
        float s = 0.f;
#pragma unroll
        for (int et = 0; et < 4; ++et) s += (o[it][et][0] + o[it][et][1]) + (o[it][et][2] + o[it][et][3]);
        s += __shfl_xor(s, 16); s += __shfl_xor(s, 32);
        const float mean = s * (1.0f / 64.0f); float q = 0.f;
#pragma unroll
        for (int et = 0; et < 4; ++et) { o[it][et] = o[it][et] - mean; q += (o[it][et][0] * o[it][et][0] + o[it][et][1] * o[it][et][1]) + (o[it][et][2] * o[it][et][2] + o[it][et][3] * o[it][et][3]); }
        q += __shfl_xor(q, 16); q += __shfl_xor(q, 32);
        const float rstd = 1.0f / sqrtf(q * (1.0f / 64.0f) + LN_EPS);
#pragma unroll
        for (int et = 0; et < 4; ++et) { const int e = hh * 64 + et * 16 + fq * 4;
            const f32x4 gg = *(const f32x4*)(INP(I_GNG) + l * 256 + e), bb = *(const f32x4*)(INP(I_GNB) + l * 256 + e);
            const u32x2 bgr = *(const u32x2*)(z + r * ZS + C_BG + e);
            const float g0 = __uint_as_float(bgr.x << 16), g1 = __uint_as_float(bgr.x & 0xffff0000u), g2 = __uint_as_float(bgr.y << 16), g3 = __uint_as_float(bgr.y & 0xffff0000u);
            const f32x4 y = o[it][et] * rstd * gg + bb;
            u32x2 wv; wv.x = pk2(y.x * g0 * sigmoidf_(g0), y.y * g1 * sigmoidf_(g1)); wv.y = pk2(y.z * g2 * sigmoidf_(g2), y.w * g3 * sigmoidf_(g3));
            *(u32x2*)(ob + r * DM + 256 + e) = wv; }
    }
    __syncthreads();
}
DI void phase_m3(const KArgs& a, int l, unsigned char* lds) {
    for (int ct = blockIdx.x; ct < NCT; ct += gridDim.x) { if (ct < 256) m3_item<false>(a, l, ct, lds); else m3_item<true>(a, l, ct, lds); }
}

#define XB_TMO      128
#define XB_XCNT(j)  (256  + 64 * (j))
#define XB_XSUB(j)  (1280 + 64 * (j))
#define XB_XGEN(j)  (2304 + 64 * (j))
#define XB_TOP      3328
#define XB_TOPGEN   3392
#define XCD_BAR_WORDS 3456
#define XB_SPIN_CAP (1u << 18)

__device__ __forceinline__ unsigned xb_ld(unsigned* p)              { return __hip_atomic_load(p, __ATOMIC_RELAXED, __HIP_MEMORY_SCOPE_AGENT); }
__device__ __forceinline__ unsigned xb_add(unsigned* p, unsigned v) { return __hip_atomic_fetch_add(p, v, __ATOMIC_RELAXED, __HIP_MEMORY_SCOPE_AGENT); }
__device__ __forceinline__ unsigned xb_xcc_id() { return (unsigned)__builtin_amdgcn_s_getreg((3 << 11) | 20) & 0xFu; }
#define XB_SPIN(cond, bar) do { unsigned _sp = 0; while (cond) { __builtin_amdgcn_s_sleep(1); \
    if ((++_sp & 255u) == 0u) { if (xb_ld(&(bar)[XB_TMO])) break; if (_sp > XB_SPIN_CAP) { atomicAdd(&(bar)[XB_TMO], 1u); break; } } } } while (0)

struct XcdBarrier {
    unsigned* bar; unsigned x;
    volatile LAS unsigned* st;
};

__device__ __forceinline__ XcdBarrier xcd_barrier_post(unsigned* bar, volatile LAS unsigned* st) {
    XcdBarrier b; b.bar = bar; b.x = xb_xcc_id(); b.st = st;
    if (threadIdx.x == 0) (void)xb_add(&bar[XB_XCNT(b.x)], 1u);
    return b;
}
__device__ __forceinline__ void xcd_barrier_complete(unsigned* bar, unsigned x, unsigned& nloc, unsigned& nx) {
    const unsigned G = gridDim.x * gridDim.y * gridDim.z;
    unsigned sum, cnt, mine, sp = 0u;
    for (;;) {
        sum = 0u; cnt = 0u; mine = 0u;
#pragma unroll
        for (unsigned j = 0; j < 16; ++j) { const unsigned c = xb_ld(&bar[XB_XCNT(j)]); sum += c; cnt += (c > 0u) ? 1u : 0u; mine = (j == x) ? c : mine; }
        if (sum == G) break;
        __builtin_amdgcn_s_sleep(1);
        if ((++sp & 255u) == 0u) { if (xb_ld(&bar[XB_TMO])) break; if (sp > XB_SPIN_CAP) { atomicAdd(&bar[XB_TMO], 1u); break; } }
    }
    nloc = mine > 0u ? mine : 1u; nx = cnt > 0u ? cnt : 1u;
}

__device__ __forceinline__ void xcd_barrier(const XcdBarrier& b) {
    asm volatile("s_waitcnt vmcnt(0)" ::: "memory");
    __syncthreads();
    if (threadIdx.x == 0) {
        unsigned* bar = b.bar;
        __builtin_amdgcn_s_waitcnt(0);
        unsigned nloc = b.st[0], nx = b.st[1];
        if (nloc == 0u) { xcd_barrier_complete(bar, b.x, nloc, nx); b.st[0] = nloc; b.st[1] = nx; }
        const unsigned old = xb_add(&bar[XB_XSUB(b.x)], 1u);
        const unsigned gen = old / nloc;
        if (old + 1u == (gen + 1u) * nloc) {
            __builtin_amdgcn_fence(__ATOMIC_RELEASE, "agent");
            asm volatile("s_waitcnt vmcnt(0)" ::: "memory");
            const unsigned og = xb_add(&bar[XB_TOP], 1u);
            const unsigned tg = og / nx;
            if (og + 1u == (tg + 1u) * nx) xb_add(&bar[XB_TOPGEN], 1u);
            else XB_SPIN(xb_ld(&bar[XB_TOPGEN]) == tg, bar);
            __builtin_amdgcn_fence(__ATOMIC_ACQUIRE, "agent");
            xb_add(&bar[XB_XGEN(b.x)], 1u);
            asm volatile("s_waitcnt vmcnt(0)" ::: "memory");
        } else {
            XB_SPIN(xb_ld(&bar[XB_XGEN(b.x)]) == gen, bar);
            __builtin_amdgcn_fence(__ATOMIC_ACQUIRE, "agent");
            asm volatile("s_waitcnt vmcnt(0)" ::: "memory");
        }
    }
    __syncthreads();
}

__global__ void __launch_bounds__(512, 2) fwd_kernel(KArgs a) {
    extern __shared__ __attribute__((aligned(16))) unsigned char lds[];
    cg::grid_group grid = cg::this_grid();
    const int tid = otid(), lane = tid & 63, wave = __builtin_amdgcn_readfirstlane(tid >> 6);
    const int G = gridDim.x, bx = blockIdx.x;
    if (tid == 0) { LAS unsigned long long* tb = (LAS unsigned long long*)((LAS unsigned char*)lds + TBL_OFF);
#pragma unroll
        for (int i = 0; i < N_IN; ++i) tb[i] = (unsigned long long)a.in[i]; }
    if (tid < 2) ((LAS unsigned*)((LAS unsigned char*)lds + MISC_OFF))[tid] = 0u;
    __syncthreads();
    XcdBarrier bar = xcd_barrier_post((unsigned*)(a.ws + WS_CTL), (volatile LAS unsigned*)((LAS unsigned char*)lds + MISC_OFF));
    phase_p0(a, lds, wave, lane);
    grid.sync();
    bf16* ohb = (bf16*)(a.ws + WS_OHB);
#pragma unroll 1
    for (int l = 0; l < NL; ++l) {
        unsigned char* wl = a.ws + WS_W + (size_t)l * WL_BYTES;
        {
            pg8::Gemm g{ohb, (const bf16*)(wl + WL_IN), MTOK, DIN, DM}; pg8::StaticOrder S; S.init(MTOK, DIN, G, bx);
            pg8::EpiZ E{(bf16*)(a.ws + WS_Z), DIN};
            pg8::gemm_phase<pg8::EpiZ, pg8::StaticOrder, true, true>((LAS unsigned char*)lds, g, S, E);
        }
        xcd_barrier(bar);
        phase_m1(a, l, lds);
        xcd_barrier(bar);
        phase_m2(a, l, lds);
        xcd_barrier(bar);
        phase_m3(a, l, lds);
        xcd_barrier(bar);
        {
            pg8::Gemm g{ohb, (const bf16*)(wl + WL_OUT), MTOK, DM, DM}; pg8::StaticOrder S; S.init(MTOK, DM, G, bx);
            pg8::EpiRes E{a.out + O_Y, DM, ALPHA};
            pg8::gemm_phase<pg8::EpiRes, pg8::StaticOrder, true, true>((LAS unsigned char*)lds, g, S, E);
        }
        xcd_barrier(bar);
        phase_ln(a, INP(I_LN1G) + l * DM, INP(I_LN1B) + l * DM, true, wave, lane);
        xcd_barrier(bar);
        {
            pg8::Gemm g{ohb, (const bf16*)(wl + WL_GU), MTOK, 2 * DFF, DM}; pg8::StaticOrder S; S.init(MTOK, 2 * DFF, G, bx);
            pg8::EpiGU E{(bf16*)(a.ws + WS_G), DFF};
            pg8::gemm_phase<pg8::EpiGU, pg8::StaticOrder, true, true>((LAS unsigned char*)lds, g, S, E);
        }
        xcd_barrier(bar);
        {
            pg8::Gemm g{(const bf16*)(a.ws + WS_G), (const bf16*)(wl + WL_D), MTOK, DM, DFF}; pg8::StaticOrder S; S.init(MTOK, DM, G, bx);
            pg8::EpiRes E{a.out + O_Y, DM, ALPHA};
            pg8::gemm_phase<pg8::EpiRes, pg8::StaticOrder, true, true>((LAS unsigned char*)lds, g, S, E);
        }
        xcd_barrier(bar);
        phase_ln(a, INP(I_LN2G) + l * DM, INP(I_LN2B) + l * DM, l + 1 < NL, wave, lane);
        if (l + 1 < NL) xcd_barrier(bar);
    }
}

extern "C" void kernel_launch(void* const* d_in, const int* in_sizes, int n_in, void* d_out, int out_size, void* d_ws, size_t ws_size, hipStream_t stream) {
    static int grid = 0;
    if (grid == 0) {
        if (n_in != N_IN || out_size != (int)O_END || ws_size < WS_END) { fprintf(stderr, "kernel_launch: unexpected sizes n_in %d out %d ws %zu\n", n_in, out_size, ws_size); grid = -1; return; }
        int dev = 0, cus = 0, per_cu = 0;
        if (hipGetDevice(&dev) != hipSuccess || hipDeviceGetAttribute(&cus, hipDeviceAttributeMultiprocessorCount, dev) != hipSuccess) { grid = -1; return; }
        if (hipFuncSetAttribute((const void*)fwd_kernel, hipFuncAttributeMaxDynamicSharedMemorySize, LDS_BYTES) != hipSuccess) { fprintf(stderr, "kernel_launch: hipFuncSetAttribute failed\n"); grid = -1; return; }
        if (hipOccupancyMaxActiveBlocksPerMultiprocessor(&per_cu, (const void*)fwd_kernel, 512, LDS_BYTES) != hipSuccess || per_cu < 1) { fprintf(stderr, "kernel_launch: occupancy query says %d\n", per_cu); per_cu = 1; }
        (void)hipGetLastError();
        grid = cus;
    }
    if (grid < 0) return;
    if (hipMemsetAsync((char*)d_ws + WS_CTL, 0, CTL_BYTES, stream) != hipSuccess) { fprintf(stderr, "kernel_launch: memset failed\n"); return; }
    KArgs a{};
    for (int i = 0; i < N_IN; ++i) a.in[i] = (const float*)d_in[i];
    a.out = (float*)d_out; a.ws = (unsigned char*)d_ws;
    void* args[] = {&a};
    hipError_t e = hipLaunchCooperativeKernel((const void*)fwd_kernel, dim3(grid), dim3(512), args, LDS_BYTES, stream);
    if (e != hipSuccess) fprintf(stderr, "cooperative launch failed: %s (grid %d)\n", hipGetErrorString(e), grid);
}
```

```cpp
#include <hip/hip_runtime.h>
#include <hip/hip_cooperative_groups.h>
#include <cstdio>
#include <cstdint>
namespace cg = cooperative_groups;
namespace pg8 {
#define PG8_LAS __attribute__((address_space(3)))
typedef unsigned short bf16_t;
typedef short bf16x8 __attribute__((ext_vector_type(8)));
typedef float f32x4 __attribute__((ext_vector_type(4)));
typedef unsigned u32x4 __attribute__((ext_vector_type(4)));
constexpr int BM = 256, BK = 64, HALF = 128, HTB = HALF * BK * 2  , STAGE_BYTES = 8 * HTB, NXCD = 8, WGM = 8;

__host__ __device__ __forceinline__ int lds_byte(int r, int c) { const int st = (r >> 4) * 2 + (c >> 5), rr = r & 15, cc = c & 31, ob = rr * 64 + cc * 2; return st * 1024 + (ob ^ (((ob >> 9) & 1) << 5)); }
__host__ __device__ __forceinline__ void stage_rc(int b, int& R, int& C) { const int st = b / 1024, sb = b % 1024, swz = sb ^ (((sb >> 9) & 1) << 5); R = (st >> 1) * 16 + swz / 64; C = (st & 1) * 32 + (swz % 64) / 2; }
__host__ __device__ __forceinline__ int perm32(int rho) { const int n = rho >> 4, i = rho & 15; return 8 * (i >> 2) + 4 * n + (i & 3); }

struct Unit { int pm, pn, kt0, nkt; };
struct Gemm { const bf16_t* A; const bf16_t* Bt; int M, N, K; };

struct StaticOrder {
    int nM, nN, nwg, G, c, nktF;
    __host__ __device__ void init(int M, int N, int K, int G_, int c_) { nM = M / BM; nN = N / BM; nwg = nM * nN; G = G_; c = c_; nktF = K / BK; }
    __host__ __device__ bool next(int i, Unit& u) const {
        const long L = (long)i * G + c; if (L >= nwg) return false;
        int wgid = (int)L; { const int q = nwg / NXCD, r = nwg % NXCD, xcd = wgid % NXCD, off = wgid / NXCD; wgid = (xcd < r ? xcd * (q + 1) : r * (q + 1) + (xcd - r) * q) + off; }
        const int nig = WGM * nN, gid = wgid / nig, fm = gid * WGM, gsz = (nM - fm) < WGM ? (nM - fm) : WGM;
        u.pm = fm + ((wgid % nig) % gsz); u.pn = (wgid % nig) / gsz; u.kt0 = 0; u.nkt = nktF; return true;
    }
    __device__ __forceinline__ void a_ready(const Unit&) const {}
    __device__ __forceinline__ void done(const Unit&) const {}
};
template <int NM, int NMF, int NN, int S, int NKTF> struct SplitOrder {
    int G, c;
    __host__ __device__ void init(int G_, int c_) { G = G_; c = c_; }
    __host__ __device__ bool next(int i, Unit& u) const {
        constexpr int nfull = NMF * NN, nu = (NM - NMF) * NN, npieces = nu * S;
        int L = i * G + c;
        if (L < nfull) {
            int wgid = L; { constexpr int q = nfull / NXCD, r = nfull % NXCD; const int xcd = wgid % NXCD, off = wgid / NXCD; wgid = (xcd < r ? xcd * (q + 1) : r * (q + 1) + (xcd - r) * q) + off; }
            constexpr int nig = WGM * NN; const int gid = wgid / nig, fm = gid * WGM, gsz = (NMF - fm) < WGM ? (NMF - fm) : WGM;
            u.pm = fm + ((wgid % nig) % gsz); u.pn = (wgid % nig) / gsz; u.kt0 = 0; u.nkt = NKTF; return true;
        }
        L -= nfull; if (L >= npieces) return false;
        const int sl = L / nu, ui = L % nu;
        u.pm = NMF + ui / NN; u.pn = ui % NN; u.nkt = NKTF / S; u.kt0 = sl * (NKTF / S); return true;
    }
    __device__ __forceinline__ void a_ready(const Unit&) const {}
    __device__ __forceinline__ void done(const Unit&) const {}
};
__device__ __forceinline__ unsigned cvt_pk_bf16(float lo, float hi) { unsigned r; asm volatile("v_cvt_pk_bf16_f32 %0, %1, %2" : "=v"(r) : "v"(lo), "v"(hi)); return r; }
typedef unsigned u32x2 __attribute__((ext_vector_type(2)));
struct EpiZ {
    static constexpr bool PERM = true, AFTER_DRAIN = false;
    bf16_t* O; int ldc;
    __device__ __forceinline__ void operator()(const f32x4 (&acc)[2][2][4][2], const Unit& u, int wr, int wc, int fr, int fq) const {
        const int row0 = u.pm * BM + wr * 64 + fr; const int col0 = u.pn * BM + wc * 32 + 8 * fq;
#pragma unroll
        for (int ai = 0; ai < 2; ++ai)
#pragma unroll
            for (int m = 0; m < 4; ++m) { bf16_t* rowp = O + (size_t)(row0 + ai * HALF + m * 16) * ldc + col0;
#pragma unroll
                for (int bj = 0; bj < 2; ++bj) { const f32x4 v0 = acc[ai][bj][m][0], v1 = acc[ai][bj][m][1];
                    u32x4 w; w.x = cvt_pk_bf16(v0[0], v0[1]); w.y = cvt_pk_bf16(v0[2], v0[3]); w.z = cvt_pk_bf16(v1[0], v1[1]); w.w = cvt_pk_bf16(v1[2], v1[3]);
                    *(u32x4*)(rowp + bj * HALF) = w; } }
    }
};
struct EpiGU {
    static constexpr bool PERM = true, AFTER_DRAIN = false;
    bf16_t* G; int ldg;
    __device__ __forceinline__ void operator()(const f32x4 (&acc)[2][2][4][2], const Unit& u, int wr, int wc, int fr, int fq) const {
        const int row0 = u.pm * BM + wr * 64 + fr; const int col0 = u.pn * (BM / 2) + wc * 16 + 4 * fq;
#pragma unroll
        for (int ai = 0; ai < 2; ++ai)
#pragma unroll
            for (int m = 0; m < 4; ++m) { bf16_t* rowp = G + (size_t)(row0 + ai * HALF + m * 16) * ldg + col0;
#pragma unroll
                for (int bj = 0; bj < 2; ++bj) { const f32x4 g = acc[ai][bj][m][0], up = acc[ai][bj][m][1]; f32x4 r;
#pragma unroll
                    for (int i = 0; i < 4; ++i) r[i] = g[i] / (1.0f + __expf(-g[i])) * up[i];
                    u32x2 w; w.x = cvt_pk_bf16(r[0], r[1]); w.y = cvt_pk_bf16(r[2], r[3]);
                    *(u32x2*)(rowp + bj * (HALF / 2)) = w; } }
    }
};
template <int NKTF> struct EpiRes {
    static constexpr bool PERM = false, AFTER_DRAIN = false;
    float* H; float* slab; int ldc; int row_tail;
    __device__ __forceinline__ void operator()(const f32x4 (&acc)[2][2][4][2], const Unit& u, int wr, int wc, int fr, int fq) const {
        const int row0 = u.pm * BM + wr * 64 + fr; const int col0 = u.pn * BM + wc * 32 + 4 * fq; const bool slice = u.nkt != NKTF;
        float* base = slice ? slab + ((size_t)(u.kt0 / u.nkt) * (size_t)(BM * 4) + (size_t)(row0 - row_tail)) * ldc + col0 : H + (size_t)row0 * ldc + col0;
#pragma unroll
        for (int ai = 0; ai < 2; ++ai)
#pragma unroll
            for (int m = 0; m < 4; ++m) { float* rowp = base + (size_t)(ai * HALF + m * 16) * ldc;
#pragma unroll
                for (int bj = 0; bj < 2; ++bj)
#pragma unroll
                    for (int n = 0; n < 2; ++n) { float* p = rowp + bj * HALF + n * 16; const f32x4 v = acc[ai][bj][m][n];
                        if (!slice) { const f32x4 b = *(const f32x4*)p; *(f32x4*)p = b + v; } else *(f32x4*)p = v; } }
    }
};
template <class Epi, class Sched, bool ALIGN_EPI = false, bool SP2 = false>
__device__ __forceinline__ void gemm_phase(PG8_LAS unsigned char* lds, const Gemm g, const Sched& S, const Epi& E) {
    int tid_ = threadIdx.x; asm volatile("" : "+v"(tid_));
    const int tid = tid_, wid = __builtin_amdgcn_readfirstlane(tid >> 6), lane = tid & 63, wr = wid >> 2, wc = wid & 3, fr = lane & 15, fq = lane >> 4;
    const int K = g.K;
    unsigned voffA[2], voffB[2];
#pragma unroll
    for (int i = 0; i < 2; ++i) { int R, C; stage_rc(tid * 16 + i * 8192, R, C); const int Rb = Epi::PERM ? ((R & ~31) + perm32(R & 31)) : R;
        voffA[i] = (unsigned)(R * K + C) * 2u; voffB[i] = (unsigned)(Rb * K + C) * 2u; }
    const size_t kstep = (size_t)(BK * 2);
    const size_t hstep = (size_t)HALF * K * 2;
    const size_t tstep = 2 * hstep;
    const unsigned ldsw = (unsigned)wid * 1024u;
    const int aoff = lds_byte(wr * 64 + fr, fq * 8), boff = lds_byte(wc * 32 + fr, fq * 8);
#define PG8_SA(b, h) (((b) * 2 + (h)) * HTB)
#define PG8_SB(b, h) ((4 + (b) * 2 + (h)) * HTB)
#define PG8_STAGE(bufoff, gbase, voff) do { _Pragma("unroll") for (int _i = 0; _i < 2; ++_i) \
        __builtin_amdgcn_global_load_lds((const unsigned*)((const char*)(gbase) + (voff)[_i]), (PG8_LAS unsigned*)(lds + (bufoff) + ldsw + _i * 8192), 16, 0, 0); } while (0)
#define PG8_LDA(dst, b, h) do { _Pragma("unroll") for (int m = 0; m < 4; ++m) _Pragma("unroll") for (int k = 0; k < 2; ++k) dst[m][k] = *(const PG8_LAS bf16x8*)(lds + PG8_SA(b, h) + aoff + m * 2048 + k * 1024); } while (0)
#define PG8_LDB(dst, b, h) do { _Pragma("unroll") for (int n = 0; n < 2; ++n) _Pragma("unroll") for (int k = 0; k < 2; ++k) dst[n][k] = *(const PG8_LAS bf16x8*)(lds + PG8_SB(b, h) + boff + n * 2048 + k * 1024); } while (0)
#define PG8_MMA(ai, bj, At, Bt) do { __builtin_amdgcn_s_setprio(1); _Pragma("unroll") for (int m = 0; m < 4; ++m) _Pragma("unroll") for (int n = 0; n < 2; ++n) _Pragma("unroll") for (int k = 0; k < 2; ++k) \
        acc[ai][bj][m][n] = __builtin_amdgcn_mfma_f32_16x16x32_bf16(Bt[n][k], At[m][k], acc[ai][bj][m][n], 0, 0, 0); __builtin_amdgcn_s_setprio(0); } while (0)
#define PG8_WAIT_V(n) asm volatile("s_waitcnt vmcnt(" #n ")" ::: "memory")
#define PG8_WAIT_L(n) asm volatile("s_waitcnt lgkmcnt(" #n ")" ::: "memory")
#define PG8_BAR __builtin_amdgcn_s_barrier()
#define PG8_SCHED __builtin_amdgcn_sched_barrier(0)
    Unit cur, nxt; int ui = 0;
    if (!S.next(0, cur)) return;
    f32x4 acc[2][2][4][2];
#pragma unroll
    for (int a = 0; a < 2; ++a)
#pragma unroll
        for (int b = 0; b < 2; ++b)
#pragma unroll
            for (int m = 0; m < 4; ++m)
#pragma unroll
                for (int n = 0; n < 2; ++n) acc[a][b][m][n] = (f32x4){0.f, 0.f, 0.f, 0.f};
    bf16x8 At[4][2], B0[2][2], B1[2][2];
    const char* cA = (const char*)g.A + (size_t)cur.pm * tstep + (size_t)cur.kt0 * kstep; const char* cB = (const char*)g.Bt + (size_t)cur.pn * tstep + (size_t)cur.kt0 * kstep;
    int nt = cur.nkt;
    S.a_ready(cur);
    if constexpr (SP2) {
        PG8_STAGE(PG8_SB(0, 0), cB, voffB); PG8_STAGE(PG8_SB(0, 1), cB + hstep, voffB); PG8_STAGE(PG8_SA(0, 0), cA, voffA); PG8_STAGE(PG8_SA(0, 1), cA + hstep, voffA);
        if (wr == 1) PG8_BAR;
        PG8_WAIT_V(2); PG8_BAR;
        PG8_STAGE(PG8_SB(1, 0), cB + kstep, voffB); PG8_STAGE(PG8_SA(1, 0), cA + kstep, voffA); PG8_STAGE(PG8_SB(1, 1), cB + hstep + kstep, voffB);
        PG8_WAIT_V(6); PG8_BAR;
    } else {
        PG8_STAGE(PG8_SB(0, 0), cB, voffB); PG8_STAGE(PG8_SA(0, 0), cA, voffA); PG8_STAGE(PG8_SB(0, 1), cB + hstep, voffB); PG8_STAGE(PG8_SA(0, 1), cA + hstep, voffA);
        if (wr == 1) PG8_BAR;
        PG8_WAIT_V(4); PG8_BAR;
        PG8_STAGE(PG8_SB(1, 0), cB + kstep, voffB); PG8_STAGE(PG8_SA(1, 0), cA + kstep, voffA); PG8_STAGE(PG8_SB(1, 1), cB + hstep + kstep, voffB);
        PG8_WAIT_V(6); PG8_BAR;
    }
    for (;;) {
        const bool has_next = S.next(ui + 1, nxt);
        const char* nA = has_next ? (const char*)g.A + (size_t)nxt.pm * tstep + (size_t)nxt.kt0 * kstep : cA; const char* nB = has_next ? (const char*)g.Bt + (size_t)nxt.pn * tstep + (size_t)nxt.kt0 * kstep : cB;
        for (int t = 0; t < nt; t += 2) {
            const bool last = (t == nt - 2);
            const char* a1 = cA + (size_t)(t + 1) * kstep;
            const char* a2 = last ? nA : cA + (size_t)(t + 2) * kstep; const char* b2 = last ? nB : cB + (size_t)(t + 2) * kstep;
            const char* a3 = a2 + kstep; const char* b3 = b2 + kstep;
            if (last && has_next) S.a_ready(nxt);
            if constexpr (SP2) {
            PG8_LDB(B0, 0, 0); PG8_LDB(B1, 0, 1); PG8_SCHED; PG8_LDA(At, 0, 0); PG8_STAGE(PG8_SA(1, 1), a1 + hstep, voffA);
            PG8_WAIT_V(8); PG8_WAIT_L(0); PG8_BAR; PG8_MMA(0, 0, At, B0); PG8_MMA(0, 1, At, B1); PG8_BAR; PG8_SCHED;
            PG8_LDA(At, 0, 1); PG8_STAGE(PG8_SB(0, 0), b2, voffB); PG8_STAGE(PG8_SB(0, 1), b2 + hstep, voffB); PG8_STAGE(PG8_SA(0, 0), a2, voffA);
            PG8_WAIT_V(8); PG8_WAIT_L(0); PG8_BAR; PG8_MMA(1, 0, At, B0); PG8_MMA(1, 1, At, B1); PG8_BAR; PG8_SCHED;
            PG8_LDB(B0, 1, 0); PG8_LDB(B1, 1, 1); PG8_SCHED; PG8_LDA(At, 1, 0); PG8_STAGE(PG8_SA(0, 1), a2 + hstep, voffA);
            PG8_WAIT_V(8); PG8_WAIT_L(0); PG8_BAR; PG8_MMA(0, 0, At, B0); PG8_MMA(0, 1, At, B1); PG8_BAR; PG8_SCHED;
            PG8_LDA(At, 1, 1); PG8_STAGE(PG8_SB(1, 0), b3, voffB); PG8_STAGE(PG8_SB(1, 1), b3 + hstep, voffB); PG8_STAGE(PG8_SA(1, 0), a3, voffA);
            PG8_WAIT_V(8); PG8_WAIT_L(0); PG8_BAR; PG8_MMA(1, 0, At, B0); PG8_MMA(1, 1, At, B1); PG8_BAR; PG8_SCHED;
            } else {
            PG8_LDB(B0, 0, 0); PG8_SCHED; PG8_LDA(At, 0, 0); PG8_STAGE(PG8_SA(1, 1), a1 + hstep, voffA);
            PG8_WAIT_L(8); PG8_BAR; PG8_WAIT_L(0); PG8_MMA(0, 0, At, B0); PG8_BAR; PG8_SCHED;
            PG8_LDB(B1, 0, 1); PG8_STAGE(PG8_SB(0, 0), b2, voffB);
            PG8_BAR; PG8_WAIT_L(0); PG8_MMA(0, 1, At, B1); PG8_BAR;
            PG8_LDA(At, 0, 1); PG8_STAGE(PG8_SA(0, 0), a2, voffA);
            PG8_BAR; PG8_WAIT_L(0); PG8_MMA(1, 0, At, B0); PG8_BAR; PG8_SCHED;
            PG8_STAGE(PG8_SB(0, 1), b2 + hstep, voffB);
            PG8_WAIT_V(6); PG8_BAR; PG8_MMA(1, 1, At, B1); PG8_BAR;
            PG8_LDB(B0, 1, 0); PG8_SCHED; PG8_LDA(At, 1, 0); PG8_STAGE(PG8_SA(0, 1), a2 + hstep, voffA);
            PG8_WAIT_L(8); PG8_BAR; PG8_WAIT_L(0); PG8_MMA(0, 0, At, B0); PG8_BAR; PG8_SCHED;
            PG8_LDB(B1, 1, 1); PG8_STAGE(PG8_SB(1, 0), b3, voffB);
            PG8_BAR; PG8_WAIT_L(0); PG8_MMA(0, 1, At, B1); PG8_BAR;
            PG8_LDA(At, 1, 1); PG8_STAGE(PG8_SA(1, 0), a3, voffA);
            PG8_BAR; PG8_WAIT_L(0); PG8_MMA(1, 0, At, B0); PG8_BAR; PG8_SCHED;
            PG8_STAGE(PG8_SB(1, 1), b3 + hstep, voffB);
            PG8_WAIT_V(6); PG8_BAR; PG8_MMA(1, 1, At, B1); PG8_BAR;
            }
        }
        if constexpr (ALIGN_EPI) { if (wr == 0) PG8_BAR; }
        if constexpr (!Epi::AFTER_DRAIN) { E(acc, cur, wr, wc, fr, fq); S.done(cur); }
        if (!has_next) break;
#pragma unroll
        for (int a = 0; a < 2; ++a)
#pragma unroll
            for (int b = 0; b < 2; ++b)
#pragma unroll
                for (int m = 0; m < 4; ++m)
#pragma unroll
                    for (int n = 0; n < 2; ++n) acc[a][b][m][n] = (f32x4){0.f, 0.f, 0.f, 0.f};
        cur = nxt; cA = nA; cB = nB; nt = cur.nkt; ++ui;
        if constexpr (ALIGN_EPI) { if (wr == 1) PG8_BAR; }
    }
    PG8_WAIT_V(0);
    if constexpr (!ALIGN_EPI) { if (wr == 0) PG8_BAR; }
    PG8_BAR;
    if constexpr (Epi::AFTER_DRAIN) { E.fused(acc, cur, wr, wc, fr, fq, lds, wid, lane); S.done(cur); }
#undef PG8_SA
#undef PG8_SB
#undef PG8_STAGE
#undef PG8_LDA
#undef PG8_LDB
#undef PG8_MMA
#undef PG8_WAIT_V
#undef PG8_WAIT_L
#undef PG8_BAR
#undef PG8_SCHED
}
}

typedef unsigned short bf16;
typedef short bf16x8 __attribute__((ext_vector_type(8)));
typedef float f32x4 __attribute__((ext_vector_type(4)));
typedef unsigned u32x4 __attribute__((ext_vector_type(4)));
typedef unsigned u32x2 __attribute__((ext_vector_type(2)));
typedef float f32x2_t __attribute__((ext_vector_type(2)));
typedef __bf16 bf16x2_t __attribute__((ext_vector_type(2)));
#define DI __device__ __forceinline__
#define LAS __attribute__((address_space(3)))

constexpr int DM = 1024, MTOK = 17408, MP = 16384, DIN = 2304, DFF = 2816, NL = 4, ZS = DIN;
constexpr int C_AX = 0, C_AG = 256, C_BQ = 512, C_BK = 768, C_BV = 1024, C_BG = 1280, C_CQ = 1536, C_CK = 2048, C_CV = 2176;
constexpr int NCT = 288;
constexpr float LN_EPS = 1e-5f;
constexpr float ALPHA = 1.681792830507429f;
constexpr int LDS_BYTES = 147456;
enum { I_XP = 0, I_XS, I_SCONV, I_SLRU, I_SRET, I_CK, I_CV, I_LNG, I_LNB, I_WIN, I_CONVW, I_CONVB, I_WRA, I_BRA, I_WRX, I_BRX, I_LAM, I_GNG, I_GNB, I_SINK, I_WOUT,
       I_LN1G, I_LN1B, I_WG, I_WU, I_WD, I_LN2G, I_LN2B, N_IN };
constexpr size_t O_Y = 0, O_PCONV = 17825792, O_PLRU = 17831936, O_PRET = 17833984, O_PK = 17965056, O_PV = 18096128, O_SCONV = 18227200, O_SLRU = 18325504,
                 O_SRET = 18358272, O_SK = 20455424, O_SV = 20979712, O_END = 21504000;
constexpr size_t WL_IN = 0, WL_OUT = 4718592, WL_GU = 6815744, WL_D = 18350080, WL_BYTES = 24117248;
constexpr size_t WS_W = 0, WS_OHB = 96468992, WS_Z = 132120576, WS_HLOC = 212336640, WS_PC = 230162432, WS_U = 247988224, WS_AS = 266862592, WS_BS = 267157504, WS_SLAB = WS_PC, SLAB_BYTES = (size_t)11 * 1024 * 1024 * 4, WS_CTL = WS_SLAB + SLAB_BYTES, CTL_BYTES = 16384, WS_GW = WS_CTL + CTL_BYTES, GW_BYTES = (size_t)2 * 4 * 4 * 4096 * 2, WS_END = WS_GW + GW_BYTES;
static_assert(WS_CTL >= 267452416, "control words above the mixer scratch");
constexpr size_t WS_G = WS_Z;

struct KArgs { const float* in[N_IN]; float* out; unsigned char* ws; };

DI int otid() { int t = threadIdx.x; asm volatile("" : "+v"(t)); return t; }
constexpr int MISC_OFF = 131072 + 512;
constexpr int TBL_OFF = 131072 + 1024;
DI const float* inp_(const unsigned char* lds, int i) {
    const LAS unsigned* t = (const LAS unsigned*)((const LAS unsigned char*)lds + TBL_OFF) + 2 * i;
    const unsigned lo = __builtin_amdgcn_readfirstlane(t[0]), hi = __builtin_amdgcn_readfirstlane(t[1]);
    return (const float*)(((unsigned long long)hi << 32) | (unsigned long long)lo);
}
#define INP(i) inp_(lds, (i))
DI float bf2f(bf16 v) { return __uint_as_float((unsigned)v << 16); }
DI unsigned pk2(float lo, float hi) { f32x2_t v = {lo, hi}; bf16x2_t b = __builtin_convertvector(v, bf16x2_t); return __builtin_bit_cast(unsigned, b); }
DI bf16x8 pack8(f32x4 a, f32x4 b) { u32x4 p; p.x = pk2(a[0], a[1]); p.y = pk2(a[2], a[3]); p.z = pk2(b[0], b[1]); p.w = pk2(b[2], b[3]); return __builtin_bit_cast(bf16x8, p); }
DI float sigmoidf_(float x) { return 1.0f / (1.0f + __expf(-x)); }
DI float gelu_tanh(float x) { const float y = 0.7978845608028654f * (x + 0.044715f * x * x * x); const float t = 1.0f - 2.0f / (__expf(2.0f * y) + 1.0f); return 0.5f * x * (1.0f + t); }
DI float wave_sum(float v) {
#pragma unroll
    for (int o = 1; o < 64; o <<= 1) v += __shfl_xor(v, o);
    return v;
}
#define MFMA16(a, b, c) __builtin_amdgcn_mfma_f32_16x16x32_bf16((a), (b), (c), 0, 0, 0)

DI void p0_transpose_item(const float* W, int K, int N, bf16* WT, int mode, LAS float* scr, int item, int lane) {
    const int nblk = N / 32, kb = item / nblk, nb = item % nblk, k0 = 64 * kb, n0 = 32 * nb;
#pragma unroll 8
    for (int i = 0; i < 32; ++i) { const int kk = 2 * i + (lane >> 5); scr[kk * 33 + (lane & 31)] = W[(size_t)(k0 + kk) * N + n0 + (lane & 31)]; }
    asm volatile("s_waitcnt lgkmcnt(0)" ::: "memory");
    const int c = lane & 7;
#pragma unroll
    for (int j = 0; j < 4; ++j) { const int n = (lane >> 3) + 8 * j; const LAS float* s = scr + (8 * c) * 33 + n;
        u32x4 o; o.x = pk2(s[0 * 33], s[1 * 33]); o.y = pk2(s[2 * 33], s[3 * 33]); o.z = pk2(s[4 * 33], s[5 * 33]); o.w = pk2(s[6 * 33], s[7 * 33]);
        const int ng = n0 + n; const int row = mode == 0 ? ng : ((ng >> 2) * 8 + (ng & 3) + (mode == 2 ? 4 : 0));
        *(u32x4*)(WT + (size_t)row * K + k0 + 8 * c) = o; }
    asm volatile("s_waitcnt lgkmcnt(0)" ::: "memory");
}
DI void ln_row(const float* xrow, const float* g, const float* b, float* hrow, bf16* hbrow, int lane, float fs) {
    const f32x4* xr = (const f32x4*)xrow + lane;
    f32x4 v[4]; float s = 0.f;
#pragma unroll
    for (int j = 0; j < 4; ++j) { v[j] = xr[64 * j]; s += (v[j].x + v[j].y) + (v[j].z + v[j].w); }
    const float mean = wave_sum(s) * (1.f / DM); float s2 = 0.f;
#pragma unroll
    for (int j = 0; j < 4; ++j) { v[j] = v[j] - mean; s2 += (v[j].x * v[j].x + v[j].y * v[j].y) + (v[j].z * v[j].z + v[j].w * v[j].w); }
    const float rstd = 1.f / sqrtf(wave_sum(s2) * (1.f / DM) + LN_EPS);
#pragma unroll
    for (int j = 0; j < 4; ++j) { const f32x4 gg = ((const f32x4*)g)[lane + 64 * j], bb = ((const f32x4*)b)[lane + 64 * j];
        const f32x4 y = v[j] * rstd * gg + bb; ((f32x4*)hrow)[lane + 64 * j] = y * fs;
        if (hbrow) { u32x2 w; w.x = pk2(y.x, y.y); w.y = pk2(y.z, y.w); ((u32x2*)hbrow)[lane + 64 * j] = w; } }
}
DI void phase_p0(const KArgs& a, unsigned char* lds, int wave, int lane) {
    LAS float* scr = (LAS float*)((LAS unsigned char*)lds + wave * 16384);
    const int gw = blockIdx.x * 8 + wave, NGW = gridDim.x * 8;
    constexpr int I_IN = 16 * 72, I_OUT = 16 * 32, I_GT = 16 * 88, I_DN = 44 * 32, I_LAYER = I_IN + I_OUT + 2 * I_GT + I_DN;
    for (int it = gw; it < NL * I_LAYER; it += NGW) {
        const int l = it / I_LAYER; int r = it % I_LAYER; unsigned char* wl = a.ws + WS_W + (size_t)l * WL_BYTES;
        if (r < I_IN) { p0_transpose_item(INP(I_WIN) + (size_t)l * DM * DIN, DM, DIN, (bf16*)(wl + WL_IN), 0, scr, r, lane); continue; } r -= I_IN;
        if (r < I_OUT) { p0_transpose_item(INP(I_WOUT) + (size_t)l * DM * DM, DM, DM, (bf16*)(wl + WL_OUT), 0, scr, r, lane); continue; } r -= I_OUT;
        if (r < I_GT) { p0_transpose_item(INP(I_WG) + (size_t)l * DM * DFF, DM, DFF, (bf16*)(wl + WL_GU), 1, scr, r, lane); continue; } r -= I_GT;
        if (r < I_GT) { p0_transpose_item(INP(I_WU) + (size_t)l * DM * DFF, DM, DFF, (bf16*)(wl + WL_GU), 2, scr, r, lane); continue; } r -= I_GT;
        p0_transpose_item(INP(I_WD) + (size_t)l * DFF * DM, DFF, DM, (bf16*)(wl + WL_D), 0, scr, r, lane);
    }
    {
        bf16* GW = (bf16*)(a.ws + WS_GW); const float* wa = INP(I_WRA); const float* wx = INP(I_WRX);
        for (int e = blockIdx.x * 512 + wave * 64 + lane; e < 2 * NL * 4 * 4096; e += gridDim.x * 512) { const int gsel = e / (NL * 4 * 4096), r = e % (NL * 4 * 4096), lh = r >> 12, j = (r >> 6) & 63, i = r & 63;
            const float v = (gsel ? wx : wa)[(size_t)lh * 4096 + i * 64 + j]; GW[e] = (bf16)(pk2(v, 0.f) & 0xffffu); } }
    float* h = a.out + O_Y; bf16* hb = (bf16*)(a.ws + WS_OHB);
    for (int m = gw; m < MTOK; m += NGW) {
        const float* xrow = m < MP ? INP(I_XP) + (size_t)m * DM : INP(I_XS) + (size_t)(m - MP) * DM;
        ln_row(xrow, INP(I_LNG), INP(I_LNB), h + (size_t)m * DM, hb + (size_t)m * DM, lane, ALPHA);
    }
}
template <int nslab> DI void phase_ln(const KArgs& a, const float* g, const float* b, bool want_bf16, int wave, int lane) {
    const float fs = want_bf16 ? ALPHA : 1.0f;
    const int gw = blockIdx.x * 8 + wave, NGW = gridDim.x * 8;
    float* h = a.out + O_Y; bf16* hb = (bf16*)(a.ws + WS_OHB);
    f32x4 gg[4], bb[4];
#pragma unroll
    for (int j = 0; j < 4; ++j) { gg[j] = ((const f32x4*)g)[lane + 64 * j]; bb[j] = ((const f32x4*)b)[lane + 64 * j]; }
    for (int m = gw; m < MTOK; m += 2 * NGW) {
        const int m1 = m + NGW; const bool two = m1 < MTOK;
        f32x4 v0[4], v1[4]; float s0 = 0.f, s1 = 0.f;
        const f32x4* x0 = (const f32x4*)(h + (size_t)m * DM) + lane; const f32x4* x1 = (const f32x4*)(h + (size_t)(two ? m1 : m) * DM) + lane;
#pragma unroll
        for (int j = 0; j < 4; ++j) { v0[j] = x0[64 * j]; v1[j] = x1[64 * j]; }
        if (m >= MP) { const f32x4* sl = (const f32x4*)((const float*)(a.ws + WS_SLAB) + (size_t)(m - MP) * DM) + lane;
#pragma unroll
            for (int s = 0; s < nslab; ++s) {
#pragma unroll
                for (int j = 0; j < 4; ++j) v0[j] += sl[(size_t)s * (1024 * 1024 / 4) + 64 * j]; } }
        if (two && m1 >= MP) { const f32x4* sl = (const f32x4*)((const float*)(a.ws + WS_SLAB) + (size_t)(m1 - MP) * DM) + lane;
#pragma unroll
            for (int s = 0; s < nslab; ++s) {
#pragma unroll
                for (int j = 0; j < 4; ++j) v1[j] += sl[(size_t)s * (1024 * 1024 / 4) + 64 * j]; } }
#pragma unroll
        for (int j = 0; j < 4; ++j) { s0 += (v0[j].x + v0[j].y) + (v0[j].z + v0[j].w); s1 += (v1[j].x + v1[j].y) + (v1[j].z + v1[j].w); }
        const float mean0 = wave_sum(s0) * (1.f / DM), mean1 = wave_sum(s1) * (1.f / DM); float q0 = 0.f, q1 = 0.f;
#pragma unroll
        for (int j = 0; j < 4; ++j) { v0[j] = v0[j] - mean0; v1[j] = v1[j] - mean1;
            q0 += (v0[j].x * v0[j].x + v0[j].y * v0[j].y) + (v0[j].z * v0[j].z + v0[j].w * v0[j].w); q1 += (v1[j].x * v1[j].x + v1[j].y * v1[j].y) + (v1[j].z * v1[j].z + v1[j].w * v1[j].w); }
        const float r0 = 1.f / sqrtf(wave_sum(q0) * (1.f / DM) + LN_EPS), r1 = 1.f / sqrtf(wave_sum(q1) * (1.f / DM) + LN_EPS);
#pragma unroll
        for (int j = 0; j < 4; ++j) { const f32x4 y = v0[j] * r0 * gg[j] + bb[j]; ((f32x4*)(h + (size_t)m * DM))[lane + 64 * j] = y * fs;
            if (want_bf16) { u32x2 w; w.x = pk2(y.x, y.y); w.y = pk2(y.z, y.w); ((u32x2*)(hb + (size_t)m * DM))[lane + 64 * j] = w; } }
        if (two) {
#pragma unroll
            for (int j = 0; j < 4; ++j) { const f32x4 y = v1[j] * r1 * gg[j] + bb[j]; ((f32x4*)(h + (size_t)m1 * DM))[lane + 64 * j] = y * fs;
                if (want_bf16) { u32x2 w; w.x = pk2(y.x, y.y); w.y = pk2(y.z, y.w); ((u32x2*)(hb + (size_t)m1 * DM))[lane + 64 * j] = w; } } }
    }
}

struct CT { int row0, L, b, n, sb; bool sample; };
DI CT ct_decode(int ct) { CT c; if (ct < 256) { c.sample = false; c.b = ct >> 7; c.n = ct & 127; c.sb = 0; c.row0 = c.b * 8192 + c.n * 64; c.L = 64; }
                          else { c.sample = true; c.sb = ct - 256; c.b = 0; c.n = 0; c.row0 = MP + c.sb * 32; c.L = 32; } return c; }
DI float lg2_gamma(int h) { return __log2f(1.0f - exp2f(-5.0f - (float)h)); }

constexpr int UBS = 264;
template <bool SAMPLE> DI void m1_a_item(const KArgs& a, int l, int ct, unsigned char* lds) {
    constexpr int L = SAMPLE ? 32 : 64, NTT = L / 16;
    const int tid = otid(), lane = tid & 63, w = tid >> 6, fr = lane & 15, fq = lane >> 4;
    const CT k = ct_decode(ct);
    bf16* axs = (bf16*)lds;
    bf16* ub = (bf16*)(lds + 36864);
    const bf16* z = (const bf16*)(a.ws + WS_Z);
    for (int p = tid; p < (L + 3) * 32; p += 512) { const int r = p >> 5, c8 = (p & 31) * 8; u32x4 raw = (u32x4){0u, 0u, 0u, 0u};
        if (r >= 3 || (!SAMPLE && k.n != 0)) raw = *(const u32x4*)(z + (size_t)(k.row0 + r - 3) * ZS + C_AX + c8);
        else if (SAMPLE) { const float* sc = INP(I_SCONV) + ((size_t)(l * 32 + k.sb) * 3 + r) * 256 + c8; const f32x4 f0 = *(const f32x4*)sc, f1 = *(const f32x4*)(sc + 4);
            raw.x = pk2(f0.x, f0.y); raw.y = pk2(f0.z, f0.w); raw.z = pk2(f1.x, f1.y); raw.w = pk2(f1.z, f1.w); }
        *(u32x4*)(axs + r * 256 + c8) = raw; }
    __syncthreads();
    {   const int c = tid & 255, half = tid >> 8; constexpr int TPH = L / 2; const int t0 = half * TPH;
        const float* cw = INP(I_CONVW) + (size_t)l * 4 * 256 + c;
        const float cw0 = cw[0], cw1 = cw[256], cw2 = cw[512], cw3 = cw[768], cb = INP(I_CONVB)[l * 256 + c];
        float x0 = bf2f(axs[(t0 + 0) * 256 + c]), x1 = bf2f(axs[(t0 + 1) * 256 + c]), x2 = bf2f(axs[(t0 + 2) * 256 + c]);
#pragma unroll 8
        for (int t = 0; t < TPH; ++t) { const float x3 = bf2f(axs[(t0 + t + 3) * 256 + c]); const float u = cb + cw0 * x0 + cw1 * x1 + cw2 * x2 + cw3 * x3;
            ub[(t0 + t) * UBS + c] = (bf16)(pk2(u, 0.f) & 0xffffu); x0 = x1; x1 = x2; x2 = x3; }
        if (half == 1) {
            if (SAMPLE) { float* o = a.out + O_SCONV + ((size_t)(l * 32 + k.sb) * 3) * 256 + c; o[0] = x0; o[256] = x1; o[512] = x2; }
            else if (k.n == 127) { float* o = a.out + O_PCONV + ((size_t)(l * 2 + k.b) * 3) * 256 + c; o[0] = x0; o[256] = x1; o[512] = x2; } }
    }
    __syncthreads();
    const int hh = w >> 1, ctb = (w & 1) * 2;
    const bf16* WT = (const bf16*)(a.ws + WS_GW) + (size_t)(l * 4 + hh) * 4096;
    f32x4 accr[2][NTT], accx[2][NTT];
    {   bf16x8 wa[2][2], wx[2][2];
#pragma unroll
        for (int c2 = 0; c2 < 2; ++c2)
#pragma unroll
            for (int kk = 0; kk < 2; ++kk) { const size_t off = (size_t)((ctb + c2) * 16 + fr) * 64 + kk * 32 + fq * 8; wa[c2][kk] = *(const bf16x8*)(WT + off); wx[c2][kk] = *(const bf16x8*)(WT + (size_t)NL * 4 * 4096 + off); }
#pragma unroll
        for (int tt = 0; tt < NTT; ++tt) {
            const bf16x8 u0 = *(const bf16x8*)(ub + (tt * 16 + fr) * UBS + hh * 64 + fq * 8), u1 = *(const bf16x8*)(ub + (tt * 16 + fr) * UBS + hh * 64 + 32 + fq * 8);
#pragma unroll
            for (int c2 = 0; c2 < 2; ++c2) { f32x4 r = (f32x4){0.f, 0.f, 0.f, 0.f}, x = (f32x4){0.f, 0.f, 0.f, 0.f};
                r = MFMA16(u0, wa[c2][0], r); r = MFMA16(u1, wa[c2][1], r); x = MFMA16(u0, wx[c2][0], x); x = MFMA16(u1, wx[c2][1], x); accr[c2][tt] = r; accx[c2][tt] = x; }
        }
    }
#pragma unroll
    for (int c2 = 0; c2 < 2; ++c2) {
        const int c = hh * 64 + (ctb + c2) * 16 + fr;
        const float ba = INP(I_BRA)[l * 256 + c], bx = INP(I_BRX)[l * 256 + c];
        const float sp = log1pf(expf(-INP(I_LAM)[l * 256 + c]));
        float PR[NTT], HR[NTT];
#pragma unroll
        for (int tt = 0; tt < NTT; ++tt) { float P = 1.f, hl = 0.f;
#pragma unroll
            for (int jj = 0; jj < 4; ++jj) { const float r = sigmoidf_(accr[c2][tt][jj] + ba), gi = sigmoidf_(accx[c2][tt][jj] + bx); const float la = -8.0f * r * sp; const float av = expf(la);
                const float uu = bf2f(ub[(tt * 16 + fq * 4 + jj) * UBS + c]);
                const float bt = sqrtf(fmaxf(-expm1f(2.0f * la), 0.f)) * gi * uu; hl = av * hl + bt; P *= av; accr[c2][tt][jj] = P; accx[c2][tt][jj] = hl; }
            PR[tt] = P; HR[tt] = hl; }
        float cP = 1.f, cH = 0.f;
        float* hloc = (float*)(a.ws + WS_HLOC) + (size_t)k.row0 * 256 + c; float* pc = (float*)(a.ws + WS_PC) + (size_t)k.row0 * 256 + c;
#pragma unroll
        for (int tt = 0; tt < NTT; ++tt) { float myP = 1.f, myH = 0.f;
#pragma unroll
            for (int q = 0; q < 4; ++q) { const float pq = __shfl(PR[tt], fr + 16 * q), hq = __shfl(HR[tt], fr + 16 * q);
                if (q == fq) { myP = cP; myH = cH; }
                cH = pq * cH + hq; cP = pq * cP; }
#pragma unroll
            for (int jj = 0; jj < 4; ++jj) { const int t = tt * 16 + fq * 4 + jj; hloc[t * 256] = accx[c2][tt][jj] + accr[c2][tt][jj] * myH; pc[t * 256] = accr[c2][tt][jj] * myP; } }
        if (fq == 0) { float* As = (float*)(a.ws + WS_AS) + ct * 256 + c; float* Bs = (float*)(a.ws + WS_BS) + ct * 256 + c;
            if (!SAMPLE) { *As = cP; *Bs = cH; }
            else { const float h0s = INP(I_SLRU)[(size_t)(l * 32 + k.sb) * 256 + c]; a.out[O_SLRU + (size_t)(l * 32 + k.sb) * 256 + c] = cP * h0s + cH; *As = cP; *Bs = h0s; } }
    }
    __syncthreads();
}

constexpr int TS = 72;
template <bool SAMPLE> DI void m1_u_item(const KArgs& a, int l, int ct, unsigned char* lds) {
    constexpr int L = SAMPLE ? 32 : 64;
    const int tid = otid(), lane = tid & 63, w = tid >> 6, fr = lane & 15, fq = lane >> 4;
    const CT k = ct_decode(ct);
    bf16* KT = (bf16*)lds;
    bf16* VT = KT + 4 * 64 * TS;
    const bf16* z = (const bf16*)(a.ws + WS_Z);
    for (int p = tid; p < L * 32; p += 512) { const int j = p >> 5, col = (p & 31) * 8;
        const u32x4 kr = *(const u32x4*)(z + (size_t)(k.row0 + j) * ZS + C_BK + col), vr = *(const u32x4*)(z + (size_t)(k.row0 + j) * ZS + C_BV + col);
        const float wj = exp2f((float)(L - 1 - j) * lg2_gamma(col >> 6)) * 0.125f;
        const unsigned k0 = pk2(__uint_as_float(kr.x << 16) * wj, __uint_as_float(kr.x & 0xffff0000u) * wj), k1 = pk2(__uint_as_float(kr.y << 16) * wj, __uint_as_float(kr.y & 0xffff0000u) * wj);
        const unsigned k2 = pk2(__uint_as_float(kr.z << 16) * wj, __uint_as_float(kr.z & 0xffff0000u) * wj), k3 = pk2(__uint_as_float(kr.w << 16) * wj, __uint_as_float(kr.w & 0xffff0000u) * wj);
        bf16* dk = KT + (size_t)col * TS + j; bf16* dv = VT + (size_t)col * TS + j;
        dk[0 * TS] = (bf16)(k0 & 0xffffu); dk[1 * TS] = (bf16)(k0 >> 16); dk[2 * TS] = (bf16)(k1 & 0xffffu); dk[3 * TS] = (bf16)(k1 >> 16);
        dk[4 * TS] = (bf16)(k2 & 0xffffu); dk[5 * TS] = (bf16)(k2 >> 16); dk[6 * TS] = (bf16)(k3 & 0xffffu); dk[7 * TS] = (bf16)(k3 >> 16);
        dv[0 * TS] = (bf16)(vr.x & 0xffffu); dv[1 * TS] = (bf16)(vr.x >> 16); dv[2 * TS] = (bf16)(vr.y & 0xffffu); dv[3 * TS] = (bf16)(vr.y >> 16);
        dv[4 * TS] = (bf16)(vr.z & 0xffffu); dv[5 * TS] = (bf16)(vr.z >> 16); dv[6 * TS] = (bf16)(vr.w & 0xffffu); dv[7 * TS] = (bf16)(vr.w >> 16); }
    __syncthreads();
    const int hh = w >> 1, dtb = (w & 1) * 2;
#pragma unroll
    for (int d2 = 0; d2 < 2; ++d2) {
        bf16x8 kf[L / 32];
#pragma unroll
        for (int ks = 0; ks < L / 32; ++ks) kf[ks] = *(const bf16x8*)(KT + (size_t)(hh * 64 + (dtb + d2) * 16 + fr) * TS + ks * 32 + fq * 8);
        const int d = (dtb + d2) * 16 + fr;
#pragma unroll
        for (int et = 0; et < 4; ++et) { f32x4 acc = (f32x4){0.f, 0.f, 0.f, 0.f};
#pragma unroll
            for (int ks = 0; ks < L / 32; ++ks) { const bf16x8 vf = *(const bf16x8*)(VT + (size_t)(hh * 64 + et * 16 + fr) * TS + ks * 32 + fq * 8); acc = MFMA16(vf, kf[ks], acc); }
            if (!SAMPLE) *(f32x4*)((float*)(a.ws + WS_U) + ((size_t)(ct * 4 + hh) * 64 + d) * 64 + et * 16 + fq * 4) = acc;
            else { const size_t idx = (((size_t)(l * 32 + k.sb) * 4 + hh) * 64 + d) * 64 + et * 16 + fq * 4; const float g32 = exp2f(32.0f * lg2_gamma(hh));
                const f32x4 s0 = *(const f32x4*)(INP(I_SRET) + idx); *(f32x4*)(a.out + O_SRET + idx) = s0 * g32 + acc; } }
    }
    __syncthreads();
}

constexpr int VS = 200;
template <bool SAMPLE> DI void m1_swa_item(const KArgs& a, int l, int ct, int kh, unsigned char* lds) {
    constexpr int NQT = SAMPLE ? 1 : 2, NKT = SAMPLE ? 10 : 12, NK = NKT * 16;
    const int tid = otid(), lane = tid & 63, w = tid >> 6, fr = lane & 15, fq = lane >> 4;
    const CT k = ct_decode(ct);
    bf16* VT = (bf16*)lds;
    const bf16* z = (const bf16*)(a.ws + WS_Z);
    const int seq0 = k.n * 64 - 128;
    for (int p = tid; p < NK * 8; p += 512) {
        const int key = p >> 3, d0 = (p & 7) * 8; u32x4 raw = (u32x4){0u, 0u, 0u, 0u};
        if constexpr (!SAMPLE) { if (seq0 + key >= 0) raw = *(const u32x4*)(z + (size_t)(k.b * 8192 + seq0 + key) * ZS + C_CV + kh * 64 + d0); }
        else { if (key < 128) { const float* cv = INP(I_CV) + (((size_t)(l * 32 + k.sb) * 128 + key) * 2 + kh) * 64 + d0; const f32x4 f0 = *(const f32x4*)cv, f1 = *(const f32x4*)(cv + 4);
                   raw.x = pk2(f0.x, f0.y); raw.y = pk2(f0.z, f0.w); raw.z = pk2(f1.x, f1.y); raw.w = pk2(f1.z, f1.w); }
               else raw = *(const u32x4*)(z + (size_t)(k.row0 + key - 128) * ZS + C_CV + kh * 64 + d0); }
        bf16* dst = VT + (size_t)d0 * VS + key;
        dst[0 * VS] = (bf16)(raw.x & 0xffffu); dst[1 * VS] = (bf16)(raw.x >> 16); dst[2 * VS] = (bf16)(raw.y & 0xffffu); dst[3 * VS] = (bf16)(raw.y >> 16);
        dst[4 * VS] = (bf16)(raw.z & 0xffffu); dst[5 * VS] = (bf16)(raw.z >> 16); dst[6 * VS] = (bf16)(raw.w & 0xffffu); dst[7 * VS] = (bf16)(raw.w >> 16);
    }
    __syncthreads();
    const int g = w >> 1, qbase = (w & 1) * (NQT * 16), hd = kh * 4 + g;
    const float slope = exp2f(-(float)(hd + 1)), sink = INP(I_SINK)[l * 8 + hd];
    bf16x8 qf[NQT][2];
#pragma unroll
    for (int qt = 0; qt < NQT; ++qt)
#pragma unroll
        for (int kk = 0; kk < 2; ++kk) qf[qt][kk] = *(const bf16x8*)(z + (size_t)(k.row0 + qbase + qt * 16 + fr) * ZS + C_CQ + hd * 64 + kk * 32 + fq * 8);
    f32x4 S[NQT][NKT];
#pragma unroll
    for (int kt = 0; kt < NKT; ++kt) {
        const int key = kt * 16 + fr; bf16x8 kf[2];
        if constexpr (!SAMPLE) { const int sp = seq0 + key; const bf16* kr = z + (size_t)(k.b * 8192 + (sp < 0 ? 0 : sp)) * ZS + C_CK + kh * 64 + fq * 8;
            kf[0] = *(const bf16x8*)kr; kf[1] = *(const bf16x8*)(kr + 32); }
        else { if (kt < 8) { const float* ck = INP(I_CK) + (((size_t)(l * 32 + k.sb) * 128 + key) * 2 + kh) * 64 + fq * 8;
                   kf[0] = pack8(*(const f32x4*)ck, *(const f32x4*)(ck + 4)); kf[1] = pack8(*(const f32x4*)(ck + 32), *(const f32x4*)(ck + 36)); }
               else { const bf16* kr = z + (size_t)(k.row0 + key - 128) * ZS + C_CK + kh * 64 + fq * 8; kf[0] = *(const bf16x8*)kr; kf[1] = *(const bf16x8*)(kr + 32); } }
#pragma unroll
        for (int qt = 0; qt < NQT; ++qt) { f32x4 s = (f32x4){0.f, 0.f, 0.f, 0.f}; s = MFMA16(kf[0], qf[qt][0], s); s = MFMA16(kf[1], qf[qt][1], s); S[qt][kt] = s; }
    }
    bf16x8 pf[NQT][NKT / 2];
#pragma unroll
    for (int qt = 0; qt < NQT; ++qt) {
        const int qi = qbase + qt * 16 + fr; float m = -3.0e38f;
#pragma unroll
        for (int kt = 0; kt < NKT; ++kt)
#pragma unroll
            for (int jj = 0; jj < 4; ++jj) { const int key = kt * 16 + fq * 4 + jj; const float dist = fabsf((float)(128 + qi - key)); float s = S[qt][kt][jj] * 0.125f - slope * dist;
                if constexpr (!SAMPLE) { if (seq0 + key < 0) s = -1e30f; }
                S[qt][kt][jj] = s; m = fmaxf(m, s); }
        m = fmaxf(m, __shfl_xor(m, 16)); m = fmaxf(m, __shfl_xor(m, 32)); m = fmaxf(m, sink);
        float sum = 0.f;
#pragma unroll
        for (int kt = 0; kt < NKT; ++kt)
#pragma unroll
            for (int jj = 0; jj < 4; ++jj) { const float e = __expf(S[qt][kt][jj] - m); S[qt][kt][jj] = e; sum += e; }
        sum += __shfl_xor(sum, 16); sum += __shfl_xor(sum, 32);
        const float inv = 1.0f / (sum + __expf(sink - m));
#pragma unroll
        for (int kb = 0; kb < NKT / 2; ++kb) pf[qt][kb] = pack8(S[qt][2 * kb] * inv, S[qt][2 * kb + 1] * inv);
    }
    bf16* ob = (bf16*)(a.ws + WS_OHB);
#pragma unroll
    for (int dt = 0; dt < 4; ++dt) {
        f32x4 o[NQT];
#pragma unroll
        for (int qt = 0; qt < NQT; ++qt) o[qt] = (f32x4){0.f, 0.f, 0.f, 0.f};
#pragma unroll
        for (int kb = 0; kb < NKT / 2; ++kb) {
            const bf16* vp = VT + (size_t)(dt * 16 + fr) * VS + kb * 32 + fq * 4;
            u32x4 vr; const u32x2 v0 = *(const u32x2*)vp, v1 = *(const u32x2*)(vp + 16); vr.x = v0.x; vr.y = v0.y; vr.z = v1.x; vr.w = v1.y;
            const bf16x8 vf = __builtin_bit_cast(bf16x8, vr);
#pragma unroll
            for (int qt = 0; qt < NQT; ++qt) o[qt] = MFMA16(vf, pf[qt][kb], o[qt]);
        }
#pragma unroll
        for (int qt = 0; qt < NQT; ++qt) { u32x2 wv; wv.x = pk2(o[qt][0], o[qt][1]); wv.y = pk2(o[qt][2], o[qt][3]);
            *(u32x2*)(ob + (size_t)(k.row0 + qbase + qt * 16 + fr) * DM + 512 + hd * 64 + dt * 16 + fq * 4) = wv; }
    }
    __syncthreads();
}

DI void phase_m1(const KArgs& a, int l, unsigned char* lds) {
    for (int it = blockIdx.x; it < 1152; it += gridDim.x) {
        if (it < 576) { const int ct = it >> 1, kh = it & 1; if (ct < 256) m1_swa_item<false>(a, l, ct, kh, lds); else m1_swa_item<true>(a, l, ct, kh, lds); }
        else if (it < 864) { const int ct = it - 576; if (ct < 256) m1_a_item<false>(a, l, ct, lds); else m1_a_item<true>(a, l, ct, lds); }
        else { const int ct = it - 864; if (ct < 256) m1_u_item<false>(a, l, ct, lds); else m1_u_item<true>(a, l, ct, lds); }
    }
}

DI void phase_m2(const KArgs& a, int l, unsigned char* lds) {
    const int tid = otid(), lane = tid & 63, w = __builtin_amdgcn_readfirstlane(tid >> 6), seg = w >> 1, el = tid & 127;
    float* xs = (float*)lds;
    for (int eb = blockIdx.x; eb < 256; eb += gridDim.x) {
        const int e0 = eb * 128, b = e0 >> 14, hh = (e0 & 16383) >> 12, de0 = e0 & 4095;
        const float g = exp2f(64.0f * lg2_gamma(hh)), g32 = exp2f(2048.0f * lg2_gamma(hh));
        float* Ub = (float*)(a.ws + WS_U) + ((size_t)(b * 128 + seg * 32) * 4 + hh) * 4096 + de0;
        float u[32];
#pragma unroll
        for (int i = 0; i < 32; ++i) u[i] = (Ub + (size_t)i * 16384)[el];
        float s = 0.f;
#pragma unroll
        for (int i = 0; i < 32; ++i) { const float t = u[i]; u[i] = s; s = g * s + t; }
        xs[seg * 128 + el] = s;
        __syncthreads();
        float c = 0.f;
#pragma unroll
        for (int q = 0; q < 3; ++q) if (q < seg) c = g32 * c + xs[q * 128 + el];
        float gp = 1.f;
#pragma unroll
        for (int i = 0; i < 32; ++i) { (Ub + (size_t)i * 16384)[el] = u[i] + gp * c; gp *= g; }
        if (seg == 3) (a.out + O_PRET + ((size_t)(l * 2 + b) * 4 + hh) * 4096 + de0)[el] = s + g32 * c;
        __syncthreads();
    }
    for (int pb = blockIdx.x; pb < 256; pb += gridDim.x) {
        const int b = pb >> 7, c0 = (pb * 2) & 255; const bool act = (w < 4) && (lane < 2); const int sg = w & 3;
        float* As = (float*)(a.ws + WS_AS) + (size_t)(b * 128 + sg * 32) * 256 + c0; float* Bs = (float*)(a.ws + WS_BS) + (size_t)(b * 128 + sg * 32) * 256 + c0;
        float av[32], bv[32]; float P = 1.f, H = 0.f;
        if (act) {
#pragma unroll
            for (int i = 0; i < 32; ++i) { av[i] = (As + i * 256)[lane]; bv[i] = (Bs + i * 256)[lane]; }
#pragma unroll
            for (int i = 0; i < 32; ++i) { const float ai = av[i], bi = bv[i]; av[i] = P; bv[i] = H; H = ai * H + bi; P = ai * P; }
            xs[512 + sg * 2 + lane] = P; xs[520 + sg * 2 + lane] = H;
        }
        __syncthreads();
        if (act) {
            float cin = 0.f;
#pragma unroll
            for (int q = 0; q < 3; ++q) if (q < sg) cin = xs[512 + q * 2 + lane] * cin + xs[520 + q * 2 + lane];
#pragma unroll
            for (int i = 0; i < 32; ++i) (Bs + i * 256)[lane] = av[i] * cin + bv[i];
            if (sg == 3) (a.out + O_PLRU + (size_t)(l * 2 + b) * 256 + c0)[lane] = P * cin + H;
        }
        __syncthreads();
    }
    {
        const bf16* z = (const bf16*)(a.ws + WS_Z);
        for (int i = blockIdx.x * 512 + tid; i < 1280 * 64; i += gridDim.x * 512) {
            const int r = i >> 6, c4 = (i & 63) * 4; int zrow; float* ok;
            if (r < 256) { const int b = r >> 7, wq = r & 127; zrow = b * 8192 + 8064 + wq; ok = a.out + (c4 < 128 ? O_PK : O_PV) + ((size_t)(l * 2 + b) * 128 + wq) * 128; }
            else { const int rs = r - 256; zrow = MP + rs; ok = a.out + (c4 < 128 ? O_SK : O_SV) + ((size_t)l * 1024 + rs) * 128; }
            const u32x2 raw = *(const u32x2*)(z + (size_t)zrow * ZS + C_CK + c4);
            f32x4 o; o.x = __uint_as_float(raw.x << 16); o.y = __uint_as_float(raw.x & 0xffff0000u); o.z = __uint_as_float(raw.y << 16); o.w = __uint_as_float(raw.y & 0xffff0000u);
            *(f32x4*)(ok + (c4 & 127)) = o;
        }
    }
}

template <bool SAMPLE> DI void m3_item(const KArgs& a, int l, int ct, unsigned char* lds) {
    constexpr int L = SAMPLE ? 32 : 64, NIT = SAMPLE ? 1 : 2, NJT = L / 16;
    const int tid = otid(), lane = tid & 63, w = tid >> 6, fr = lane & 15, fq = lane >> 4;
    const CT k = ct_decode(ct);
    const bf16* z = (const bf16*)(a.ws + WS_Z);
    bf16* ob = (bf16*)(a.ws + WS_OHB);
    bf16* VT = (bf16*)lds;
    bf16* ST = VT + 4 * 64 * TS;
    { const int c4 = (tid & 63) * 4; const f32x4 hin = *(const f32x4*)((const float*)(a.ws + WS_BS) + ct * 256 + c4);
      for (int t = tid >> 6; t < L; t += 8) { const size_t r = (size_t)(k.row0 + t);
          const f32x4 hl = *(const f32x4*)((const float*)(a.ws + WS_HLOC) + r * 256 + c4), pc = *(const f32x4*)((const float*)(a.ws + WS_PC) + r * 256 + c4);
          const u32x2 ag = *(const u32x2*)(z + r * ZS + C_AG + c4);
          const f32x4 hv = hl + pc * hin;
          u32x2 o; o.x = pk2(hv.x * gelu_tanh(__uint_as_float(ag.x << 16)), hv.y * gelu_tanh(__uint_as_float(ag.x & 0xffff0000u)));
          o.y = pk2(hv.z * gelu_tanh(__uint_as_float(ag.y << 16)), hv.w * gelu_tanh(__uint_as_float(ag.y & 0xffff0000u)));
          *(u32x2*)(ob + r * DM + c4) = o; } }
    for (int p = tid; p < L * 32; p += 512) { const int j = p >> 5, col = (p & 31) * 8;
        const u32x4 raw = *(const u32x4*)(z + (size_t)(k.row0 + j) * ZS + C_BV + col); bf16* dst = VT + (size_t)col * TS + j;
        dst[0 * TS] = (bf16)(raw.x & 0xffffu); dst[1 * TS] = (bf16)(raw.x >> 16); dst[2 * TS] = (bf16)(raw.y & 0xffffu); dst[3 * TS] = (bf16)(raw.y >> 16);
        dst[4 * TS] = (bf16)(raw.z & 0xffffu); dst[5 * TS] = (bf16)(raw.z >> 16); dst[6 * TS] = (bf16)(raw.w & 0xffffu); dst[7 * TS] = (bf16)(raw.w >> 16); }
    { const float* Sp = SAMPLE ? INP(I_SRET) + (size_t)(l * 32 + k.sb) * 16384 : (const float*)(a.ws + WS_U) + (size_t)ct * 16384;
      for (int p = tid; p < 4096; p += 512) { const int hh = p >> 10, d = (p >> 4) & 63, e0 = (p & 15) * 4; const f32x4 s = *(const f32x4*)(Sp + (size_t)(hh * 64 + d) * 64 + e0);
          bf16* dst = ST + (size_t)(hh * 64 + e0) * TS + d; const unsigned p0 = pk2(s.x, s.y), p1 = pk2(s.z, s.w);
          dst[0 * TS] = (bf16)(p0 & 0xffffu); dst[1 * TS] = (bf16)(p0 >> 16); dst[2 * TS] = (bf16)(p1 & 0xffffu); dst[3 * TS] = (bf16)(p1 >> 16); } }
    __syncthreads();
    const int hh = w >> 1, half = w & 1; const float lg = lg2_gamma(hh);
    bf16x8 qf[NIT][2];
#pragma unroll
    for (int it = 0; it < NIT; ++it)
#pragma unroll
        for (int kk = 0; kk < 2; ++kk) qf[it][kk] = *(const bf16x8*)(z + (size_t)(k.row0 + half * (NIT * 16) + it * 16 + fr) * ZS + C_BQ + hh * 64 + kk * 32 + fq * 8);
    bf16x8 pf[NIT][NJT / 2];
    {   f32x4 S[NIT][NJT];
#pragma unroll
        for (int jt = 0; jt < NJT; ++jt) { const bf16* kr = z + (size_t)(k.row0 + jt * 16 + fr) * ZS + C_BK + hh * 64 + fq * 8;
            const bf16x8 kf0 = *(const bf16x8*)kr, kf1 = *(const bf16x8*)(kr + 32);
#pragma unroll
            for (int it = 0; it < NIT; ++it) { f32x4 s = (f32x4){0.f, 0.f, 0.f, 0.f}; s = MFMA16(kf0, qf[it][0], s); s = MFMA16(kf1, qf[it][1], s);
                const int i = half * (NIT * 16) + it * 16 + fr;
#pragma unroll
                for (int jj = 0; jj < 4; ++jj) { const int dij = i - (jt * 16 + fq * 4 + jj); s[jj] = dij >= 0 ? s[jj] * 0.125f * exp2f((float)dij * lg) : 0.f; }
                S[it][jt] = s; } }
#pragma unroll
        for (int it = 0; it < NIT; ++it)
#pragma unroll
            for (int jb = 0; jb < NJT / 2; ++jb) pf[it][jb] = pack8(S[it][2 * jb], S[it][2 * jb + 1]);
    }
    f32x4 o[NIT][4];
#pragma unroll
    for (int et = 0; et < 4; ++et) {
        f32x4 oi[NIT], oc[NIT];
#pragma unroll
        for (int it = 0; it < NIT; ++it) { oi[it] = (f32x4){0.f, 0.f, 0.f, 0.f}; oc[it] = (f32x4){0.f, 0.f, 0.f, 0.f}; }
#pragma unroll
        for (int jb = 0; jb < NJT / 2; ++jb) { const bf16* vp = VT + (size_t)(hh * 64 + et * 16 + fr) * TS + jb * 32 + fq * 4;
            u32x4 vr; const u32x2 v0 = *(const u32x2*)vp, v1 = *(const u32x2*)(vp + 16); vr.x = v0.x; vr.y = v0.y; vr.z = v1.x; vr.w = v1.y; const bf16x8 vf = __builtin_bit_cast(bf16x8, vr);
#pragma unroll
            for (int it = 0; it < NIT; ++it) oi[it] = MFMA16(vf, pf[it][jb], oi[it]); }
#pragma unroll
        for (int kk = 0; kk < 2; ++kk) { const bf16x8 sf = *(const bf16x8*)(ST + (size_t)(hh * 64 + et * 16 + fr) * TS + kk * 32 + fq * 8);
#pragma unroll
            for (int it = 0; it < NIT; ++it) oc[it] = MFMA16(sf, qf[it][kk], oc[it]); }
#pragma unroll
        for (int it = 0; it < NIT; ++it) { const int i = half * (NIT * 16) + it * 16 + fr; o[it][et] = oi[it] + oc[it] * exp2f((float)(i + 1) * lg); }
    }
#pragma unroll
    for (int it = 0; it < NIT; ++it) {
        const int i = half * (NIT * 16) + it * 16 + fr; const size_t r = (size_t)(k.row0 + i);
        float s = 0.f;
#pragma unroll
        for (int et = 0; et < 4; ++et) s += (o[it][et][0] + o[it][et][1]) + (o[it][et][2] + o[it][et][3]);
        s += __shfl_xor(s, 16); s += __shfl_xor(s, 32);
        const float mean = s * (1.0f / 64.0f); float q = 0.f;
#pragma unroll
        for (int et = 0; et < 4; ++et) { o[it][et] = o[it][et] - mean; q += (o[it][et][0] * o[it][et][0] + o[it][et][1] * o[it][et][1]) + (o[it][et][2] * o[it][et][2] + o[it][et][3] * o[it][et][3]); }
        q += __shfl_xor(q, 16); q += __shfl_xor(q, 32);
        const float rstd = 1.0f / sqrtf(q * (1.0f / 64.0f) + LN_EPS);
#pragma unroll
        for (int et = 0; et < 4; ++et) { const int e = hh * 64 + et * 16 + fq * 4;
            const f32x4 gg = *(const f32x4*)(INP(I_GNG) + l * 256 + e), bb = *(const f32x4*)(INP(I_GNB) + l * 256 + e);
            const u32x2 bgr = *(const u32x2*)(z + r * ZS + C_BG + e);
            const float g0 = __uint_as_float(bgr.x << 16), g1 = __uint_as_float(bgr.x & 0xffff0000u), g2 = __uint_as_float(bgr.y << 16), g3 = __uint_as_float(bgr.y & 0xffff0000u);
            const f32x4 y = o[it][et] * rstd * gg + bb;
            u32x2 wv; wv.x = pk2(y.x * g0 * sigmoidf_(g0), y.y * g1 * sigmoidf_(g1)); wv.y = pk2(y.z * g2 * sigmoidf_(g2), y.w * g3 * sigmoidf_(g3));
            *(u32x2*)(ob + r * DM + 256 + e) = wv; }
    }
    __syncthreads();
}
DI void phase_m3(const KArgs& a, int l, unsigned char* lds) {
    for (int ct = blockIdx.x; ct < NCT; ct += gridDim.x) { if (ct < 256) m3_item<false>(a, l, ct, lds); else m3_item<true>(a, l, ct, lds); }
}

#define XB_TMO      128
#define XB_XCNT(j)  (256  + 64 * (j))
#define XB_XSUB(j)  (1280 + 64 * (j))
#define XB_XGEN(j)  (2304 + 64 * (j))
#define XB_TOP      3328
#define XB_TOPGEN   3392
#define XCD_BAR_WORDS 3456
#define XB_SPIN_CAP (1u << 18)

__device__ __forceinline__ unsigned xb_ld(unsigned* p)              { return __hip_atomic_load(p, __ATOMIC_RELAXED, __HIP_MEMORY_SCOPE_AGENT); }
__device__ __forceinline__ unsigned xb_add(unsigned* p, unsigned v) { return __hip_atomic_fetch_add(p, v, __ATOMIC_RELAXED, __HIP_MEMORY_SCOPE_AGENT); }
__device__ __forceinline__ unsigned xb_xcc_id() { return (unsigned)__builtin_amdgcn_s_getreg((3 << 11) | 20) & 0xFu; }
#define XB_SPIN(cond, bar) do { unsigned _sp = 0; while (cond) { __builtin_amdgcn_s_sleep(1); \
    if ((++_sp & 255u) == 0u) { if (xb_ld(&(bar)[XB_TMO])) break; if (_sp > XB_SPIN_CAP) { atomicAdd(&(bar)[XB_TMO], 1u); break; } } } } while (0)

struct XcdBarrier {
    unsigned* bar; unsigned x;
    volatile LAS unsigned* st;
};

__device__ __forceinline__ XcdBarrier xcd_barrier_post(unsigned* bar, volatile LAS unsigned* st) {
    XcdBarrier b; b.bar = bar; b.x = xb_xcc_id(); b.st = st;
    if (threadIdx.x == 0) (void)xb_add(&bar[XB_XCNT(b.x)], 1u);
    return b;
}
__device__ __forceinline__ void xcd_barrier_complete(unsigned* bar, unsigned x, unsigned& nloc, unsigned& nx) {
    const unsigned G = gridDim.x * gridDim.y * gridDim.z;
    unsigned sum, cnt, mine, sp = 0u;
    for (;;) {
        sum = 0u; cnt = 0u; mine = 0u;
#pragma unroll
        for (unsigned j = 0; j < 16; ++j) { const unsigned c = xb_ld(&bar[XB_XCNT(j)]); sum += c; cnt += (c > 0u) ? 1u : 0u; mine = (j == x) ? c : mine; }
        if (sum == G) break;
        __builtin_amdgcn_s_sleep(1);
        if ((++sp & 255u) == 0u) { if (xb_ld(&bar[XB_TMO])) break; if (sp > XB_SPIN_CAP) { atomicAdd(&bar[XB_TMO], 1u); break; } }
    }
    nloc = mine > 0u ? mine : 1u; nx = cnt > 0u ? cnt : 1u;
}

__device__ __forceinline__ void xcd_barrier(const XcdBarrier& b) {
    asm volatile("s_waitcnt vmcnt(0)" ::: "memory");
    __syncthreads();
    if (threadIdx.x == 0) {
        unsigned* bar = b.bar;
        __builtin_amdgcn_s_waitcnt(0);
        unsigned nloc = b.st[0], nx = b.st[1];
        if (nloc == 0u) { xcd_barrier_complete(bar, b.x, nloc, nx); b.st[0] = nloc; b.st[1] = nx; }
        const unsigned old = xb_add(&bar[XB_XSUB(b.x)], 1u);
        const unsigned gen = old / nloc;
        if (old + 1u == (gen + 1u) * nloc) {
            __builtin_amdgcn_fence(__ATOMIC_RELEASE, "agent");
            asm volatile("s_waitcnt vmcnt(0)" ::: "memory");
            const unsigned og = xb_add(&bar[XB_TOP], 1u);
            const unsigned tg = og / nx;
            if (og + 1u == (tg + 1u) * nx) xb_add(&bar[XB_TOPGEN], 1u);
            else XB_SPIN(xb_ld(&bar[XB_TOPGEN]) == tg, bar);
            __builtin_amdgcn_fence(__ATOMIC_ACQUIRE, "agent");
            xb_add(&bar[XB_XGEN(b.x)], 1u);
            asm volatile("s_waitcnt vmcnt(0)" ::: "memory");
        } else {
            XB_SPIN(xb_ld(&bar[XB_XGEN(b.x)]) == gen, bar);
            __builtin_amdgcn_fence(__ATOMIC_ACQUIRE, "agent");
            asm volatile("s_waitcnt vmcnt(0)" ::: "memory");
        }
    }
    __syncthreads();
}

__global__ void __launch_bounds__(512, 2) fwd_kernel(KArgs a) {
    extern __shared__ __attribute__((aligned(16))) unsigned char lds[];
    cg::grid_group grid = cg::this_grid();
    const int tid = otid(), lane = tid & 63, wave = __builtin_amdgcn_readfirstlane(tid >> 6);
    const int G = gridDim.x, bx = blockIdx.x;
    if (tid == 0) { LAS unsigned long long* tb = (LAS unsigned long long*)((LAS unsigned char*)lds + TBL_OFF);
#pragma unroll
        for (int i = 0; i < N_IN; ++i) tb[i] = (unsigned long long)a.in[i]; }
    if (tid < 2) ((LAS unsigned*)((LAS unsigned char*)lds + MISC_OFF))[tid] = 0u;
    __syncthreads();
    XcdBarrier bar = xcd_barrier_post((unsigned*)(a.ws + WS_CTL), (volatile LAS unsigned*)((LAS unsigned char*)lds + MISC_OFF));
    phase_p0(a, lds, wave, lane);
    grid.sync();
    bf16* ohb = (bf16*)(a.ws + WS_OHB);
#pragma unroll 1
    for (int l = 0; l < NL; ++l) {
        unsigned char* wl = a.ws + WS_W + (size_t)l * WL_BYTES;
        {
            pg8::Gemm g{ohb, (const bf16*)(wl + WL_IN), MTOK, DIN, DM}; typedef pg8::SplitOrder<68, 68, 9, 1, 16> SO; SO S; S.init(G, bx);
            pg8::EpiZ E{(bf16*)(a.ws + WS_Z), DIN};
            pg8::gemm_phase<pg8::EpiZ, SO, true, true>((LAS unsigned char*)lds, g, S, E);
        }
        xcd_barrier(bar);
        phase_m1(a, l, lds);
        xcd_barrier(bar);
        phase_m2(a, l, lds);
        xcd_barrier(bar);
        phase_m3(a, l, lds);
        xcd_barrier(bar);
        {
            pg8::Gemm g{ohb, (const bf16*)(wl + WL_OUT), MTOK, DM, DM}; typedef pg8::SplitOrder<68, 64, 4, 4, 16> SO; SO S; S.init(G, bx);
            pg8::EpiRes<16> E{a.out + O_Y, (float*)(a.ws + WS_SLAB), DM, MP};
            pg8::gemm_phase<pg8::EpiRes<16>, SO, true, true>((LAS unsigned char*)lds, g, S, E);
        }
        xcd_barrier(bar);
        phase_ln<4>(a, INP(I_LN1G) + l * DM, INP(I_LN1B) + l * DM, true, wave, lane);
        xcd_barrier(bar);
        {
            pg8::Gemm g{ohb, (const bf16*)(wl + WL_GU), MTOK, 2 * DFF, DM}; typedef pg8::SplitOrder<68, 68, 22, 1, 16> SO; SO S; S.init(G, bx);
            pg8::EpiGU E{(bf16*)(a.ws + WS_G), DFF};
            pg8::gemm_phase<pg8::EpiGU, SO, true, true>((LAS unsigned char*)lds, g, S, E);
        }
        xcd_barrier(bar);
        {
            pg8::Gemm g{(const bf16*)(a.ws + WS_G), (const bf16*)(wl + WL_D), MTOK, DM, DFF}; typedef pg8::SplitOrder<68, 64, 4, 11, 44> SO; SO S; S.init(G, bx);
            pg8::EpiRes<44> E{a.out + O_Y, (float*)(a.ws + WS_SLAB), DM, MP};
            pg8::gemm_phase<pg8::EpiRes<44>, SO, true, true>((LAS unsigned char*)lds, g, S, E);
        }
        xcd_barrier(bar);
        phase_ln<11>(a, INP(I_LN2G) + l * DM, INP(I_LN2B) + l * DM, l + 1 < NL, wave, lane);
        if (l + 1 < NL) xcd_barrier(bar);
    }
}

extern "C" void kernel_launch(void* const* d_in, const int* in_sizes, int n_in, void* d_out, int out_size, void* d_ws, size_t ws_size, hipStream_t stream) {
    static int grid = 0;
    if (grid == 0) {
        if (n_in != N_IN || out_size != (int)O_END || ws_size < WS_END) { fprintf(stderr, "kernel_launch: unexpected sizes n_in %d out %d ws %zu\n", n_in, out_size, ws_size); grid = -1; return; }
        int dev = 0, cus = 0, per_cu = 0;
        if (hipGetDevice(&dev) != hipSuccess || hipDeviceGetAttribute(&cus, hipDeviceAttributeMultiprocessorCount, dev) != hipSuccess) { grid = -1; return; }
        if (hipFuncSetAttribute((const void*)fwd_kernel, hipFuncAttributeMaxDynamicSharedMemorySize, LDS_BYTES) != hipSuccess) { fprintf(stderr, "kernel_launch: hipFuncSetAttribute failed\n"); grid = -1; return; }
        if (hipOccupancyMaxActiveBlocksPerMultiprocessor(&per_cu, (const void*)fwd_kernel, 512, LDS_BYTES) != hipSuccess || per_cu < 1) { fprintf(stderr, "kernel_launch: occupancy query says %d\n", per_cu); per_cu = 1; }
        (void)hipGetLastError();
        grid = cus;
    }
    if (grid < 0) return;
    if (hipMemsetAsync((char*)d_ws + WS_CTL, 0, CTL_BYTES, stream) != hipSuccess) { fprintf(stderr, "kernel_launch: memset failed\n"); return; }
    KArgs a{};
    for (int i = 0; i < N_IN; ++i) a.in[i] = (const float*)d_in[i];
    a.out = (float*)d_out; a.ws = (unsigned char*)d_ws;
    void* args[] = {&a};
    hipError_t e = hipLaunchCooperativeKernel((const void*)fwd_kernel, dim3(grid), dim3(512), args, LDS_BYTES, stream);
    if (e != hipSuccess) fprintf(stderr, "cooperative launch failed: %s (grid %d)\n", hipGetErrorString(e), grid);
}
```

```cpp
#include <hip/hip_runtime.h>
#include <hip/hip_cooperative_groups.h>
#include <cstdio>
#include <cstdint>
namespace cg = cooperative_groups;
namespace pg8 {
#define PG8_LAS __attribute__((address_space(3)))
typedef unsigned short bf16_t;
typedef short bf16x8 __attribute__((ext_vector_type(8)));
typedef float f32x4 __attribute__((ext_vector_type(4)));
typedef unsigned u32x4 __attribute__((ext_vector_type(4)));
constexpr int BM = 256, BK = 64, HALF = 128, HTB = HALF * BK * 2  , STAGE_BYTES = 8 * HTB, NXCD = 8, WGM = 8;

__host__ __device__ __forceinline__ int lds_byte(int r, int c) { const int st = (r >> 4) * 2 + (c >> 5), rr = r & 15, cc = c & 31, ob = rr * 64 + cc * 2; return st * 1024 + (ob ^ (((ob >> 9) & 1) << 5)); }
__host__ __device__ __forceinline__ void stage_rc(int b, int& R, int& C) { const int st = b / 1024, sb = b % 1024, swz = sb ^ (((sb >> 9) & 1) << 5); R = (st >> 1) * 16 + swz / 64; C = (st & 1) * 32 + (swz % 64) / 2; }
__host__ __device__ __forceinline__ int perm32(int rho) { const int n = rho >> 4, i = rho & 15; return 8 * (i >> 2) + 4 * n + (i & 3); }

struct Unit { int pm, pn, kt0, nkt; };
struct Gemm { const bf16_t* A; const bf16_t* Bt; int M, N, K; };

struct StaticOrder {
    int nM, nN, nwg, G, c, nktF;
    __host__ __device__ void init(int M, int N, int K, int G_, int c_) { nM = M / BM; nN = N / BM; nwg = nM * nN; G = G_; c = c_; nktF = K / BK; }
    __host__ __device__ bool next(int i, Unit& u) const {
        const long L = (long)i * G + c; if (L >= nwg) return false;
        int wgid = (int)L; { const int q = nwg / NXCD, r = nwg % NXCD, xcd = wgid % NXCD, off = wgid / NXCD; wgid = (xcd < r ? xcd * (q + 1) : r * (q + 1) + (xcd - r) * q) + off; }
        const int nig = WGM * nN, gid = wgid / nig, fm = gid * WGM, gsz = (nM - fm) < WGM ? (nM - fm) : WGM;
        u.pm = fm + ((wgid % nig) % gsz); u.pn = (wgid % nig) / gsz; u.kt0 = 0; u.nkt = nktF; return true;
    }
    __device__ __forceinline__ void a_ready(const Unit&) const {}
    __device__ __forceinline__ void done(const Unit&) const {}
};
template <int NM, int NMF, int NN, int S, int NKTF> struct SplitOrder {
    int G, c;
    __host__ __device__ void init(int G_, int c_) { G = G_; c = c_; }
    __host__ __device__ bool next(int i, Unit& u) const {
        constexpr int nfull = NMF * NN, nu = (NM - NMF) * NN, npieces = nu * S;
        int L = i * G + c;
        if (L < nfull) {
            int wgid = L; { constexpr int q = nfull / NXCD, r = nfull % NXCD; const int xcd = wgid % NXCD, off = wgid / NXCD; wgid = (xcd < r ? xcd * (q + 1) : r * (q + 1) + (xcd - r) * q) + off; }
            constexpr int nig = WGM * NN; const int gid = wgid / nig, fm = gid * WGM, gsz = (NMF - fm) < WGM ? (NMF - fm) : WGM;
            u.pm = fm + ((wgid % nig) % gsz); u.pn = (wgid % nig) / gsz; u.kt0 = 0; u.nkt = NKTF; return true;
        }
        L -= nfull; if (L >= npieces) return false;
        const int sl = L / nu, ui = L % nu;
        u.pm = NMF + ui / NN; u.pn = ui % NN; u.nkt = NKTF / S; u.kt0 = sl * (NKTF / S); return true;
    }
    __device__ __forceinline__ void a_ready(const Unit&) const {}
    __device__ __forceinline__ void done(const Unit&) const {}
};
__device__ __forceinline__ unsigned cvt_pk_bf16(float lo, float hi) { unsigned r; asm volatile("v_cvt_pk_bf16_f32 %0, %1, %2" : "=v"(r) : "v"(lo), "v"(hi)); return r; }
typedef unsigned u32x2 __attribute__((ext_vector_type(2)));
struct EpiZ {
    static constexpr bool PERM = true, AFTER_DRAIN = false;
    bf16_t* O; int ldc;
    __device__ __forceinline__ void operator()(const f32x4 (&acc)[2][2][4][2], const Unit& u, int wr, int wc, int fr, int fq) const {
        const int row0 = u.pm * BM + wr * 64 + fr; const int col0 = u.pn * BM + wc * 32 + 8 * fq;
#pragma unroll
        for (int ai = 0; ai < 2; ++ai)
#pragma unroll
            for (int m = 0; m < 4; ++m) { bf16_t* rowp = O + (size_t)(row0 + ai * HALF + m * 16) * ldc + col0;
#pragma unroll
                for (int bj = 0; bj < 2; ++bj) { const f32x4 v0 = acc[ai][bj][m][0], v1 = acc[ai][bj][m][1];
                    u32x4 w; w.x = cvt_pk_bf16(v0[0], v0[1]); w.y = cvt_pk_bf16(v0[2], v0[3]); w.z = cvt_pk_bf16(v1[0], v1[1]); w.w = cvt_pk_bf16(v1[2], v1[3]);
                    *(u32x4*)(rowp + bj * HALF) = w; } }
    }
};
struct EpiGU {
    static constexpr bool PERM = true, AFTER_DRAIN = false;
    bf16_t* G; int ldg;
    __device__ __forceinline__ void operator()(const f32x4 (&acc)[2][2][4][2], const Unit& u, int wr, int wc, int fr, int fq) const {
        const int row0 = u.pm * BM + wr * 64 + fr; const int col0 = u.pn * (BM / 2) + wc * 16 + 4 * fq;
#pragma unroll
        for (int ai = 0; ai < 2; ++ai)
#pragma unroll
            for (int m = 0; m < 4; ++m) { bf16_t* rowp = G + (size_t)(row0 + ai * HALF + m * 16) * ldg + col0;
#pragma unroll
                for (int bj = 0; bj < 2; ++bj) { const f32x4 g = acc[ai][bj][m][0], up = acc[ai][bj][m][1]; f32x4 r;
#pragma unroll
                    for (int i = 0; i < 4; ++i) r[i] = g[i] / (1.0f + __expf(-g[i])) * up[i];
                    u32x2 w; w.x = cvt_pk_bf16(r[0], r[1]); w.y = cvt_pk_bf16(r[2], r[3]);
                    *(u32x2*)(rowp + bj * (HALF / 2)) = w; } }
    }
};
template <int NKTF> struct EpiRes {
    static constexpr bool PERM = false, AFTER_DRAIN = false;
    float* H; float* slab; int ldc; int row_tail;
    __device__ __forceinline__ void operator()(const f32x4 (&acc)[2][2][4][2], const Unit& u, int wr, int wc, int fr, int fq) const {
        const int row0 = u.pm * BM + wr * 64 + fr; const int col0 = u.pn * BM + wc * 32 + 4 * fq; const bool slice = u.nkt != NKTF;
        float* base = slice ? slab + ((size_t)(u.kt0 / u.nkt) * (size_t)(BM * 4) + (size_t)(row0 - row_tail)) * ldc + col0 : H + (size_t)row0 * ldc + col0;
#pragma unroll
        for (int ai = 0; ai < 2; ++ai)
#pragma unroll
            for (int m = 0; m < 4; ++m) { float* rowp = base + (size_t)(ai * HALF + m * 16) * ldc;
#pragma unroll
                for (int bj = 0; bj < 2; ++bj)
#pragma unroll
                    for (int n = 0; n < 2; ++n) { float* p = rowp + bj * HALF + n * 16; const f32x4 v = acc[ai][bj][m][n];
                        if (!slice) { const f32x4 b = *(const f32x4*)p; *(f32x4*)p = b + v; } else *(f32x4*)p = v; } }
    }
};
template <class Epi, class Sched, bool ALIGN_EPI = false, bool SP2 = false>
__device__ __forceinline__ void gemm_phase(PG8_LAS unsigned char* lds, const Gemm g, const Sched& S, const Epi& E) {
    int tid_ = threadIdx.x; asm volatile("" : "+v"(tid_));
    const int tid = tid_, wid = __builtin_amdgcn_readfirstlane(tid >> 6), lane = tid & 63, wr = wid >> 2, wc = wid & 3, fr = lane & 15, fq = lane >> 4;
    const int K = g.K;
    unsigned voffA[2], voffB[2];
#pragma unroll
    for (int i = 0; i < 2; ++i) { int R, C; stage_rc(tid * 16 + i * 8192, R, C); const int Rb = Epi::PERM ? ((R & ~31) + perm32(R & 31)) : R;
        voffA[i] = (unsigned)(R * K + C) * 2u; voffB[i] = (unsigned)(Rb * K + C) * 2u; }
    const size_t kstep = (size_t)(BK * 2);
    const size_t hstep = (size_t)HALF * K * 2;
    const size_t tstep = 2 * hstep;
    const unsigned ldsw = (unsigned)wid * 1024u;
    const int aoff = lds_byte(wr * 64 + fr, fq * 8), boff = lds_byte(wc * 32 + fr, fq * 8);
#define PG8_SA(b, h) (((b) * 2 + (h)) * HTB)
#define PG8_SB(b, h) ((4 + (b) * 2 + (h)) * HTB)
#define PG8_STAGE(bufoff, gbase, voff) do { _Pragma("unroll") for (int _i = 0; _i < 2; ++_i) \
        __builtin_amdgcn_global_load_lds((const unsigned*)((const char*)(gbase) + (voff)[_i]), (PG8_LAS unsigned*)(lds + (bufoff) + ldsw + _i * 8192), 16, 0, 0); } while (0)
#define PG8_LDA(dst, b, h) do { _Pragma("unroll") for (int m = 0; m < 4; ++m) _Pragma("unroll") for (int k = 0; k < 2; ++k) dst[m][k] = *(const PG8_LAS bf16x8*)(lds + PG8_SA(b, h) + aoff + m * 2048 + k * 1024); } while (0)
#define PG8_LDB(dst, b, h) do { _Pragma("unroll") for (int n = 0; n < 2; ++n) _Pragma("unroll") for (int k = 0; k < 2; ++k) dst[n][k] = *(const PG8_LAS bf16x8*)(lds + PG8_SB(b, h) + boff + n * 2048 + k * 1024); } while (0)
#define PG8_MMA(ai, bj, At, Bt) do { __builtin_amdgcn_s_setprio(1); _Pragma("unroll") for (int m = 0; m < 4; ++m) _Pragma("unroll") for (int n = 0; n < 2; ++n) _Pragma("unroll") for (int k = 0; k < 2; ++k) \
        acc[ai][bj][m][n] = __builtin_amdgcn_mfma_f32_16x16x32_bf16(Bt[n][k], At[m][k], acc[ai][bj][m][n], 0, 0, 0); __builtin_amdgcn_s_setprio(0); } while (0)
#define PG8_WAIT_V(n) asm volatile("s_waitcnt vmcnt(" #n ")" ::: "memory")
#define PG8_WAIT_L(n) asm volatile("s_waitcnt lgkmcnt(" #n ")" ::: "memory")
#define PG8_BAR __builtin_amdgcn_s_barrier()
#define PG8_SCHED __builtin_amdgcn_sched_barrier(0)
    Unit cur, nxt; int ui = 0;
    if (!S.next(0, cur)) return;
    f32x4 acc[2][2][4][2];
#pragma unroll
    for (int a = 0; a < 2; ++a)
#pragma unroll
        for (int b = 0; b < 2; ++b)
#pragma unroll
            for (int m = 0; m < 4; ++m)
#pragma unroll
                for (int n = 0; n < 2; ++n) acc[a][b][m][n] = (f32x4){0.f, 0.f, 0.f, 0.f};
    bf16x8 At[4][2], B0[2][2], B1[2][2];
    const char* cA = (const char*)g.A + (size_t)cur.pm * tstep + (size_t)cur.kt0 * kstep; const char* cB = (const char*)g.Bt + (size_t)cur.pn * tstep + (size_t)cur.kt0 * kstep;
    int nt = cur.nkt;
    S.a_ready(cur);
    if constexpr (SP2) {
        PG8_STAGE(PG8_SB(0, 0), cB, voffB); PG8_STAGE(PG8_SB(0, 1), cB + hstep, voffB); PG8_STAGE(PG8_SA(0, 0), cA, voffA); PG8_STAGE(PG8_SA(0, 1), cA + hstep, voffA);
        if (wr == 1) PG8_BAR;
        PG8_WAIT_V(2); PG8_BAR;
        PG8_STAGE(PG8_SB(1, 0), cB + kstep, voffB); PG8_STAGE(PG8_SA(1, 0), cA + kstep, voffA); PG8_STAGE(PG8_SB(1, 1), cB + hstep + kstep, voffB);
        PG8_WAIT_V(6); PG8_BAR;
    } else {
        PG8_STAGE(PG8_SB(0, 0), cB, voffB); PG8_STAGE(PG8_SA(0, 0), cA, voffA); PG8_STAGE(PG8_SB(0, 1), cB + hstep, voffB); PG8_STAGE(PG8_SA(0, 1), cA + hstep, voffA);
        if (wr == 1) PG8_BAR;
        PG8_WAIT_V(4); PG8_BAR;
        PG8_STAGE(PG8_SB(1, 0), cB + kstep, voffB); PG8_STAGE(PG8_SA(1, 0), cA + kstep, voffA); PG8_STAGE(PG8_SB(1, 1), cB + hstep + kstep, voffB);
        PG8_WAIT_V(6); PG8_BAR;
    }
    for (;;) {
        const bool has_next = S.next(ui + 1, nxt);
        const char* nA = has_next ? (const char*)g.A + (size_t)nxt.pm * tstep + (size_t)nxt.kt0 * kstep : cA; const char* nB = has_next ? (const char*)g.Bt + (size_t)nxt.pn * tstep + (size_t)nxt.kt0 * kstep : cB;
        for (int t = 0; t < nt; t += 2) {
            const bool last = (t == nt - 2);
            const char* a1 = cA + (size_t)(t + 1) * kstep;
            const char* a2 = last ? nA : cA + (size_t)(t + 2) * kstep; const char* b2 = last ? nB : cB + (size_t)(t + 2) * kstep;
            const char* a3 = a2 + kstep; const char* b3 = b2 + kstep;
            if (last && has_next) S.a_ready(nxt);
            if constexpr (SP2) {
            PG8_LDB(B0, 0, 0); PG8_LDB(B1, 0, 1); PG8_SCHED; PG8_LDA(At, 0, 0); PG8_STAGE(PG8_SA(1, 1), a1 + hstep, voffA);
            PG8_WAIT_V(8); PG8_WAIT_L(0); PG8_BAR; PG8_MMA(0, 0, At, B0); PG8_MMA(0, 1, At, B1); PG8_BAR; PG8_SCHED;
            PG8_LDA(At, 0, 1); PG8_STAGE(PG8_SB(0, 0), b2, voffB); PG8_STAGE(PG8_SB(0, 1), b2 + hstep, voffB); PG8_STAGE(PG8_SA(0, 0), a2, voffA);
            PG8_WAIT_V(8); PG8_WAIT_L(0); PG8_BAR; PG8_MMA(1, 0, At, B0); PG8_MMA(1, 1, At, B1); PG8_BAR; PG8_SCHED;
            PG8_LDB(B0, 1, 0); PG8_LDB(B1, 1, 1); PG8_SCHED; PG8_LDA(At, 1, 0); PG8_STAGE(PG8_SA(0, 1), a2 + hstep, voffA);
            PG8_WAIT_V(8); PG8_WAIT_L(0); PG8_BAR; PG8_MMA(0, 0, At, B0); PG8_MMA(0, 1, At, B1); PG8_BAR; PG8_SCHED;
            PG8_LDA(At, 1, 1); PG8_STAGE(PG8_SB(1, 0), b3, voffB); PG8_STAGE(PG8_SB(1, 1), b3 + hstep, voffB); PG8_STAGE(PG8_SA(1, 0), a3, voffA);
            PG8_WAIT_V(8); PG8_WAIT_L(0); PG8_BAR; PG8_MMA(1, 0, At, B0); PG8_MMA(1, 1, At, B1); PG8_BAR; PG8_SCHED;
            } else {
            PG8_LDB(B0, 0, 0); PG8_SCHED; PG8_LDA(At, 0, 0); PG8_STAGE(PG8_SA(1, 1), a1 + hstep, voffA);
            PG8_WAIT_L(8); PG8_BAR; PG8_WAIT_L(0); PG8_MMA(0, 0, At, B0); PG8_BAR; PG8_SCHED;
            PG8_LDB(B1, 0, 1); PG8_STAGE(PG8_SB(0, 0), b2, voffB);
            PG8_BAR; PG8_WAIT_L(0); PG8_MMA(0, 1, At, B1); PG8_BAR;
            PG8_LDA(At, 0, 1); PG8_STAGE(PG8_SA(0, 0), a2, voffA);
            PG8_BAR; PG8_WAIT_L(0); PG8_MMA(1, 0, At, B0); PG8_BAR; PG8_SCHED;
            PG8_STAGE(PG8_SB(0, 1), b2 + hstep, voffB);
            PG8_WAIT_V(6); PG8_BAR; PG8_MMA(1, 1, At, B1); PG8_BAR;
            PG8_LDB(B0, 1, 0); PG8_SCHED; PG8_LDA(At, 1, 0); PG8_STAGE(PG8_SA(0, 1), a2 + hstep, voffA);
            PG8_WAIT_L(8); PG8_BAR; PG8_WAIT_L(0); PG8_MMA(0, 0, At, B0); PG8_BAR; PG8_SCHED;
            PG8_LDB(B1, 1, 1); PG8_STAGE(PG8_SB(1, 0), b3, voffB);
            PG8_BAR; PG8_WAIT_L(0); PG8_MMA(0, 1, At, B1); PG8_BAR;
            PG8_LDA(At, 1, 1); PG8_STAGE(PG8_SA(1, 0), a3, voffA);
            PG8_BAR; PG8_WAIT_L(0); PG8_MMA(1, 0, At, B0); PG8_BAR; PG8_SCHED;
            PG8_STAGE(PG8_SB(1, 1), b3 + hstep, voffB);
            PG8_WAIT_V(6); PG8_BAR; PG8_MMA(1, 1, At, B1); PG8_BAR;
            }
        }
        if constexpr (ALIGN_EPI) { if (wr == 0) PG8_BAR; }
        if constexpr (!Epi::AFTER_DRAIN) { E(acc, cur, wr, wc, fr, fq); S.done(cur); }
        if (!has_next) break;
#pragma unroll
        for (int a = 0; a < 2; ++a)
#pragma unroll
            for (int b = 0; b < 2; ++b)
#pragma unroll
                for (int m = 0; m < 4; ++m)
#pragma unroll
                    for (int n = 0; n < 2; ++n) acc[a][b][m][n] = (f32x4){0.f, 0.f, 0.f, 0.f};
        cur = nxt; cA = nA; cB = nB; nt = cur.nkt; ++ui;
        if constexpr (ALIGN_EPI) { if (wr == 1) PG8_BAR; }
    }
    PG8_WAIT_V(0);
    if constexpr (!ALIGN_EPI) { if (wr == 0) PG8_BAR; }
    PG8_BAR;
    if constexpr (Epi::AFTER_DRAIN) { E.fused(acc, cur, wr, wc, fr, fq, lds, wid, lane); S.done(cur); }
#undef PG8_SA
#undef PG8_SB
#undef PG8_STAGE
#undef PG8_LDA
#undef PG8_LDB
#undef PG8_MMA
#undef PG8_WAIT_V
#undef PG8_WAIT_L
#undef PG8_BAR
#undef PG8_SCHED
}
}

typedef unsigned short bf16;
typedef short bf16x8 __attribute__((ext_vector_type(8)));
typedef float f32x4 __attribute__((ext_vector_type(4)));
typedef unsigned u32x4 __attribute__((ext_vector_type(4)));
typedef unsigned u32x2 __attribute__((ext_vector_type(2)));
typedef float f32x2_t __attribute__((ext_vector_type(2)));
typedef __bf16 bf16x2_t __attribute__((ext_vector_type(2)));
#define DI __device__ __forceinline__
#define LAS __attribute__((address_space(3)))

constexpr int DM = 1024, MTOK = 17408, MP = 16384, DIN = 2304, DFF = 2816, NL = 4, ZS = DIN;
constexpr int C_AX = 0, C_AG = 256, C_BQ = 512, C_BK = 768, C_BV = 1024, C_BG = 1280, C_CQ = 1536, C_CK = 2048, C_CV = 2176;
constexpr int NCT = 288;
constexpr float LN_EPS = 1e-5f;
constexpr float ALPHA = 1.681792830507429f;
constexpr int LDS_BYTES = 147456;
enum { I_XP = 0, I_XS, I_SCONV, I_SLRU, I_SRET, I_CK, I_CV, I_LNG, I_LNB, I_WIN, I_CONVW, I_CONVB, I_WRA, I_BRA, I_WRX, I_BRX, I_LAM, I_GNG, I_GNB, I_SINK, I_WOUT,
       I_LN1G, I_LN1B, I_WG, I_WU, I_WD, I_LN2G, I_LN2B, N_IN };
constexpr size_t O_Y = 0, O_PCONV = 17825792, O_PLRU = 17831936, O_PRET = 17833984, O_PK = 17965056, O_PV = 18096128, O_SCONV = 18227200, O_SLRU = 18325504,
                 O_SRET = 18358272, O_SK = 20455424, O_SV = 20979712, O_END = 21504000;
constexpr size_t WL_IN = 0, WL_OUT = 4718592, WL_GU = 6815744, WL_D = 18350080, WL_BYTES = 24117248;
constexpr size_t WS_W = 0, WS_OHB = 96468992, WS_Z = 132120576, WS_HLOC = 212336640, WS_PC = 230162432, WS_U = 247988224, WS_AS = 266862592, WS_BS = 267157504, WS_SLAB = WS_PC, SLAB_BYTES = (size_t)11 * 1024 * 1024 * 4, WS_CTL = WS_SLAB + SLAB_BYTES, CTL_BYTES = 16384, WS_GW = WS_CTL + CTL_BYTES, GW_BYTES = (size_t)2 * 4 * 4 * 4096 * 2, WS_END = WS_GW + GW_BYTES;
static_assert(WS_CTL >= 267452416, "control words above the mixer scratch");
constexpr size_t WS_G = WS_Z;

struct KArgs { const float* in[N_IN]; float* out; unsigned char* ws; };

DI int otid() { int t = threadIdx.x; asm volatile("" : "+v"(t)); return t; }
constexpr int MISC_OFF = 131072 + 512;
constexpr int TBL_OFF = 131072 + 1024;
DI const float* inp_(const unsigned char* lds, int i) {
    const LAS unsigned* t = (const LAS unsigned*)((const LAS unsigned char*)lds + TBL_OFF) + 2 * i;
    const unsigned lo = __builtin_amdgcn_readfirstlane(t[0]), hi = __builtin_amdgcn_readfirstlane(t[1]);
    return (const float*)(((unsigned long long)hi << 32) | (unsigned long long)lo);
}
#define INP(i) inp_(lds, (i))
DI float bf2f(bf16 v) { return __uint_as_float((unsigned)v << 16); }
DI unsigned pk2(float lo, float hi) { f32x2_t v = {lo, hi}; bf16x2_t b = __builtin_convertvector(v, bf16x2_t); return __builtin_bit_cast(unsigned, b); }
DI bf16x8 pack8(f32x4 a, f32x4 b) { u32x4 p; p.x = pk2(a[0], a[1]); p.y = pk2(a[2], a[3]); p.z = pk2(b[0], b[1]); p.w = pk2(b[2], b[3]); return __builtin_bit_cast(bf16x8, p); }
DI float sigmoidf_(float x) { return 1.0f / (1.0f + __expf(-x)); }
DI float gelu_tanh(float x) { const float y = 0.7978845608028654f * (x + 0.044715f * x * x * x); const float t = 1.0f - 2.0f / (__expf(2.0f * y) + 1.0f); return 0.5f * x * (1.0f + t); }
DI float wave_sum(float v) {
#pragma unroll
    for (int o = 1; o < 64; o <<= 1) v += __shfl_xor(v, o);
    return v;
}
typedef short s16x4 __attribute__((ext_vector_type(4)));
DI s16x4 tr_blk(const bf16* base, int rs, int fr) { return __builtin_bit_cast(s16x4, __builtin_amdgcn_ds_read_tr16_b64_v4i16((LAS s16x4*)(base + (fr >> 2) * rs + 4 * (fr & 3)))); }
DI bf16x8 cat8(s16x4 a, s16x4 b) { return __builtin_shufflevector(a, b, 0, 1, 2, 3, 4, 5, 6, 7); }
DI u32x4 pack8u(f32x4 a, f32x4 b) { u32x4 p; p.x = pk2(a[0], a[1]); p.y = pk2(a[2], a[3]); p.z = pk2(b[0], b[1]); p.w = pk2(b[2], b[3]); return p; }
DI float lo16f(unsigned v) { return __uint_as_float(v << 16); }
DI float hi16f(unsigned v) { return __uint_as_float(v & 0xffff0000u); }
#define MFMA16(a, b, c) __builtin_amdgcn_mfma_f32_16x16x32_bf16((a), (b), (c), 0, 0, 0)

DI void p0_transpose_item(const float* W, int K, int N, bf16* WT, int mode, LAS float* scr, int item, int lane) {
    const int nblk = N / 32, kb = item / nblk, nb = item % nblk, k0 = 64 * kb, n0 = 32 * nb;
#pragma unroll 8
    for (int i = 0; i < 32; ++i) { const int kk = 2 * i + (lane >> 5); scr[kk * 33 + (lane & 31)] = W[(size_t)(k0 + kk) * N + n0 + (lane & 31)]; }
    asm volatile("s_waitcnt lgkmcnt(0)" ::: "memory");
    const int c = lane & 7;
#pragma unroll
    for (int j = 0; j < 4; ++j) { const int n = (lane >> 3) + 8 * j; const LAS float* s = scr + (8 * c) * 33 + n;
        u32x4 o; o.x = pk2(s[0 * 33], s[1 * 33]); o.y = pk2(s[2 * 33], s[3 * 33]); o.z = pk2(s[4 * 33], s[5 * 33]); o.w = pk2(s[6 * 33], s[7 * 33]);
        const int ng = n0 + n; const int row = mode == 0 ? ng : ((ng >> 2) * 8 + (ng & 3) + (mode == 2 ? 4 : 0));
        *(u32x4*)(WT + (size_t)row * K + k0 + 8 * c) = o; }
    asm volatile("s_waitcnt lgkmcnt(0)" ::: "memory");
}
DI void ln_row(const float* xrow, const float* g, const float* b, float* hrow, bf16* hbrow, int lane, float fs) {
    const f32x4* xr = (const f32x4*)xrow + lane;
    f32x4 v[4]; float s = 0.f;
#pragma unroll
    for (int j = 0; j < 4; ++j) { v[j] = xr[64 * j]; s += (v[j].x + v[j].y) + (v[j].z + v[j].w); }
    const float mean = wave_sum(s) * (1.f / DM); float s2 = 0.f;
#pragma unroll
    for (int j = 0; j < 4; ++j) { v[j] = v[j] - mean; s2 += (v[j].x * v[j].x + v[j].y * v[j].y) + (v[j].z * v[j].z + v[j].w * v[j].w); }
    const float rstd = 1.f / sqrtf(wave_sum(s2) * (1.f / DM) + LN_EPS);
#pragma unroll
    for (int j = 0; j < 4; ++j) { const f32x4 gg = ((const f32x4*)g)[lane + 64 * j], bb = ((const f32x4*)b)[lane + 64 * j];
        const f32x4 y = v[j] * rstd * gg + bb; ((f32x4*)hrow)[lane + 64 * j] = y * fs;
        if (hbrow) { u32x2 w; w.x = pk2(y.x, y.y); w.y = pk2(y.z, y.w); ((u32x2*)hbrow)[lane + 64 * j] = w; } }
}
DI void phase_p0(const KArgs& a, unsigned char* lds, int wave, int lane) {
    LAS float* scr = (LAS float*)((LAS unsigned char*)lds + wave * 16384);
    const int gw = blockIdx.x * 8 + wave, NGW = gridDim.x * 8;
    constexpr int I_IN = 16 * 72, I_OUT = 16 * 32, I_GT = 16 * 88, I_DN = 44 * 32, I_LAYER = I_IN + I_OUT + 2 * I_GT + I_DN;
    for (int it = gw; it < NL * I_LAYER; it += NGW) {
        const int l = it / I_LAYER; int r = it % I_LAYER; unsigned char* wl = a.ws + WS_W + (size_t)l * WL_BYTES;
        if (r < I_IN) { p0_transpose_item(INP(I_WIN) + (size_t)l * DM * DIN, DM, DIN, (bf16*)(wl + WL_IN), 0, scr, r, lane); continue; } r -= I_IN;
        if (r < I_OUT) { p0_transpose_item(INP(I_WOUT) + (size_t)l * DM * DM, DM, DM, (bf16*)(wl + WL_OUT), 0, scr, r, lane); continue; } r -= I_OUT;
        if (r < I_GT) { p0_transpose_item(INP(I_WG) + (size_t)l * DM * DFF, DM, DFF, (bf16*)(wl + WL_GU), 1, scr, r, lane); continue; } r -= I_GT;
        if (r < I_GT) { p0_transpose_item(INP(I_WU) + (size_t)l * DM * DFF, DM, DFF, (bf16*)(wl + WL_GU), 2, scr, r, lane); continue; } r -= I_GT;
        p0_transpose_item(INP(I_WD) + (size_t)l * DFF * DM, DFF, DM, (bf16*)(wl + WL_D), 0, scr, r, lane);
    }
    {
        bf16* GW = (bf16*)(a.ws + WS_GW); const float* wa = INP(I_WRA); const float* wx = INP(I_WRX);
        for (int e = blockIdx.x * 512 + wave * 64 + lane; e < 2 * NL * 4 * 4096; e += gridDim.x * 512) { const int gsel = e / (NL * 4 * 4096), r = e % (NL * 4 * 4096), lh = r >> 12, j = (r >> 6) & 63, i = r & 63;
            const float v = (gsel ? wx : wa)[(size_t)lh * 4096 + i * 64 + j]; GW[e] = (bf16)(pk2(v, 0.f) & 0xffffu); } }
    float* h = a.out + O_Y; bf16* hb = (bf16*)(a.ws + WS_OHB);
    for (int m = gw; m < MTOK; m += NGW) {
        const float* xrow = m < MP ? INP(I_XP) + (size_t)m * DM : INP(I_XS) + (size_t)(m - MP) * DM;
        ln_row(xrow, INP(I_LNG), INP(I_LNB), h + (size_t)m * DM, hb + (size_t)m * DM, lane, ALPHA);
    }
}
template <int nslab> DI void phase_ln(const KArgs& a, const float* g, const float* b, bool want_bf16, int wave, int lane) {
    const float fs = want_bf16 ? ALPHA : 1.0f;
    const int gw = blockIdx.x * 8 + wave, NGW = gridDim.x * 8;
    float* h = a.out + O_Y; bf16* hb = (bf16*)(a.ws + WS_OHB);
    f32x4 gg[4], bb[4];
#pragma unroll
    for (int j = 0; j < 4; ++j) { gg[j] = ((const f32x4*)g)[lane + 64 * j]; bb[j] = ((const f32x4*)b)[lane + 64 * j]; }
    for (int m = gw; m < MTOK; m += 2 * NGW) {
        const int m1 = m + NGW; const bool two = m1 < MTOK;
        f32x4 v0[4], v1[4]; float s0 = 0.f, s1 = 0.f;
        const f32x4* x0 = (const f32x4*)(h + (size_t)m * DM) + lane; const f32x4* x1 = (const f32x4*)(h + (size_t)(two ? m1 : m) * DM) + lane;
#pragma unroll
        for (int j = 0; j < 4; ++j) { v0[j] = x0[64 * j]; v1[j] = x1[64 * j]; }
        if (m >= MP) { const f32x4* sl = (const f32x4*)((const float*)(a.ws + WS_SLAB) + (size_t)(m - MP) * DM) + lane;
#pragma unroll
            for (int s = 0; s < nslab; ++s) {
#pragma unroll
                for (int j = 0; j < 4; ++j) v0[j] += sl[(size_t)s * (1024 * 1024 / 4) + 64 * j]; } }
        if (two && m1 >= MP) { const f32x4* sl = (const f32x4*)((const float*)(a.ws + WS_SLAB) + (size_t)(m1 - MP) * DM) + lane;
#pragma unroll
            for (int s = 0; s < nslab; ++s) {
#pragma unroll
                for (int j = 0; j < 4; ++j) v1[j] += sl[(size_t)s * (1024 * 1024 / 4) + 64 * j]; } }
#pragma unroll
        for (int j = 0; j < 4; ++j) { s0 += (v0[j].x + v0[j].y) + (v0[j].z + v0[j].w); s1 += (v1[j].x + v1[j].y) + (v1[j].z + v1[j].w); }
        const float mean0 = wave_sum(s0) * (1.f / DM), mean1 = wave_sum(s1) * (1.f / DM); float q0 = 0.f, q1 = 0.f;
#pragma unroll
        for (int j = 0; j < 4; ++j) { v0[j] = v0[j] - mean0; v1[j] = v1[j] - mean1;
            q0 += (v0[j].x * v0[j].x + v0[j].y * v0[j].y) + (v0[j].z * v0[j].z + v0[j].w * v0[j].w); q1 += (v1[j].x * v1[j].x + v1[j].y * v1[j].y) + (v1[j].z * v1[j].z + v1[j].w * v1[j].w); }
        const float r0 = 1.f / sqrtf(wave_sum(q0) * (1.f / DM) + LN_EPS), r1 = 1.f / sqrtf(wave_sum(q1) * (1.f / DM) + LN_EPS);
#pragma unroll
        for (int j = 0; j < 4; ++j) { const f32x4 y = v0[j] * r0 * gg[j] + bb[j]; ((f32x4*)(h + (size_t)m * DM))[lane + 64 * j] = y * fs;
            if (want_bf16) { u32x2 w; w.x = pk2(y.x, y.y); w.y = pk2(y.z, y.w); ((u32x2*)(hb + (size_t)m * DM))[lane + 64 * j] = w; } }
        if (two) {
#pragma unroll
            for (int j = 0; j < 4; ++j) { const f32x4 y = v1[j] * r1 * gg[j] + bb[j]; ((f32x4*)(h + (size_t)m1 * DM))[lane + 64 * j] = y * fs;
                if (want_bf16) { u32x2 w; w.x = pk2(y.x, y.y); w.y = pk2(y.z, y.w); ((u32x2*)(hb + (size_t)m1 * DM))[lane + 64 * j] = w; } } }
    }
}

struct CT { int row0, L, b, n, sb; bool sample; };
DI CT ct_decode(int ct) { CT c; if (ct < 256) { c.sample = false; c.b = ct >> 7; c.n = ct & 127; c.sb = 0; c.row0 = c.b * 8192 + c.n * 64; c.L = 64; }
                          else { c.sample = true; c.sb = ct - 256; c.b = 0; c.n = 0; c.row0 = MP + c.sb * 32; c.L = 32; } return c; }
DI float lg2_gamma(int h) { return __log2f(1.0f - exp2f(-5.0f - (float)h)); }

constexpr int UBS = 264;
template <bool SAMPLE> DI void m1_a_item(const KArgs& a, int l, int ct, unsigned char* lds) {
    constexpr int L = SAMPLE ? 32 : 64, NTT = L / 16;
    const int tid = otid(), lane = tid & 63, w = tid >> 6, fr = lane & 15, fq = lane >> 4;
    const CT k = ct_decode(ct);
    bf16* axs = (bf16*)lds;
    bf16* ub = (bf16*)(lds + 36864);
    const bf16* z = (const bf16*)(a.ws + WS_Z);
    {   constexpr int NP = ((L + 3) * 32 + 511) / 512; u32x4 raw[NP];
#pragma unroll
        for (int i = 0; i < NP; ++i) { const int p = tid + 512 * i, r = p >> 5, c8 = (p & 31) * 8; raw[i] = (u32x4){0u, 0u, 0u, 0u};
            if (p < (L + 3) * 32) {
                if (r >= 3 || (!SAMPLE && k.n != 0)) raw[i] = *(const u32x4*)(z + (size_t)(k.row0 + r - 3) * ZS + C_AX + c8);
                else if (SAMPLE) { const float* sc = INP(I_SCONV) + ((size_t)(l * 32 + k.sb) * 3 + r) * 256 + c8; raw[i] = pack8u(*(const f32x4*)sc, *(const f32x4*)(sc + 4)); } } }
#pragma unroll
        for (int i = 0; i < NP; ++i) { const int p = tid + 512 * i, r = p >> 5, c8 = (p & 31) * 8; if (p < (L + 3) * 32) *(u32x4*)(axs + r * 256 + c8) = raw[i]; } }
    __syncthreads();
    {   const int c = tid & 255, half = tid >> 8; constexpr int TPH = L / 2; const int t0 = half * TPH;
        const float* cw = INP(I_CONVW) + (size_t)l * 4 * 256 + c;
        const float cw0 = cw[0], cw1 = cw[256], cw2 = cw[512], cw3 = cw[768], cb = INP(I_CONVB)[l * 256 + c];
        float x0 = bf2f(axs[(t0 + 0) * 256 + c]), x1 = bf2f(axs[(t0 + 1) * 256 + c]), x2 = bf2f(axs[(t0 + 2) * 256 + c]);
#pragma unroll 8
        for (int t = 0; t < TPH; ++t) { const float x3 = bf2f(axs[(t0 + t + 3) * 256 + c]); const float u = cb + cw0 * x0 + cw1 * x1 + cw2 * x2 + cw3 * x3;
            ub[(t0 + t) * UBS + c] = (bf16)(pk2(u, 0.f) & 0xffffu); x0 = x1; x1 = x2; x2 = x3; }
        if (half == 1) {
            if (SAMPLE) { float* o = a.out + O_SCONV + ((size_t)(l * 32 + k.sb) * 3) * 256 + c; o[0] = x0; o[256] = x1; o[512] = x2; }
            else if (k.n == 127) { float* o = a.out + O_PCONV + ((size_t)(l * 2 + k.b) * 3) * 256 + c; o[0] = x0; o[256] = x1; o[512] = x2; } }
    }
    __syncthreads();
    const int hh = w >> 1, ctb = (w & 1) * 2;
    const bf16* WT = (const bf16*)(a.ws + WS_GW) + (size_t)(l * 4 + hh) * 4096;
    f32x4 accr[2][NTT], accx[2][NTT];
    {   bf16x8 wa[2][2], wx[2][2];
#pragma unroll
        for (int c2 = 0; c2 < 2; ++c2)
#pragma unroll
            for (int kk = 0; kk < 2; ++kk) { const size_t off = (size_t)((ctb + c2) * 16 + fr) * 64 + kk * 32 + fq * 8; wa[c2][kk] = *(const bf16x8*)(WT + off); wx[c2][kk] = *(const bf16x8*)(WT + (size_t)NL * 4 * 4096 + off); }
#pragma unroll
        for (int tt = 0; tt < NTT; ++tt) {
            const bf16x8 u0 = *(const bf16x8*)(ub + (tt * 16 + fr) * UBS + hh * 64 + fq * 8), u1 = *(const bf16x8*)(ub + (tt * 16 + fr) * UBS + hh * 64 + 32 + fq * 8);
#pragma unroll
            for (int c2 = 0; c2 < 2; ++c2) { f32x4 r = (f32x4){0.f, 0.f, 0.f, 0.f}, x = (f32x4){0.f, 0.f, 0.f, 0.f};
                r = MFMA16(u0, wa[c2][0], r); r = MFMA16(u1, wa[c2][1], r); x = MFMA16(u0, wx[c2][0], x); x = MFMA16(u1, wx[c2][1], x); accr[c2][tt] = r; accx[c2][tt] = x; }
        }
    }
#pragma unroll
    for (int c2 = 0; c2 < 2; ++c2) {
        const int c = hh * 64 + (ctb + c2) * 16 + fr;
        const float ba = INP(I_BRA)[l * 256 + c], bx = INP(I_BRX)[l * 256 + c];
        const float sp8 = -8.0f * log1pf(__expf(-INP(I_LAM)[l * 256 + c]));
        float PR[NTT], HR[NTT];
#pragma unroll
        for (int tt = 0; tt < NTT; ++tt) { float P = 1.f, hl = 0.f;
#pragma unroll
            for (int jj = 0; jj < 4; ++jj) { const float r = sigmoidf_(accr[c2][tt][jj] + ba), gi = sigmoidf_(accx[c2][tt][jj] + bx); const float la = r * sp8; const float av = __expf(la);
                const float uu = bf2f(ub[(tt * 16 + fq * 4 + jj) * UBS + c]);
                const float x2 = 2.0f * la;
                const float om = x2 > -0.25f ? -x2 * (1.0f + x2 * (0.5f + x2 * (0.16666667f + x2 * (0.041666668f + x2 * 0.008333334f)))) : 1.0f - av * av;
                const float bt = sqrtf(fmaxf(om, 0.f)) * gi * uu; hl = av * hl + bt; P *= av; accr[c2][tt][jj] = P; accx[c2][tt][jj] = hl; }
            PR[tt] = P; HR[tt] = hl; }
        float cP = 1.f, cH = 0.f;
        float* hloc = (float*)(a.ws + WS_HLOC) + (size_t)k.row0 * 256 + c; float* pc = (float*)(a.ws + WS_PC) + (size_t)k.row0 * 256 + c;
#pragma unroll
        for (int tt = 0; tt < NTT; ++tt) { float myP = 1.f, myH = 0.f;
#pragma unroll
            for (int q = 0; q < 4; ++q) { const float pq = __shfl(PR[tt], fr + 16 * q), hq = __shfl(HR[tt], fr + 16 * q);
                if (q == fq) { myP = cP; myH = cH; }
                cH = pq * cH + hq; cP = pq * cP; }
#pragma unroll
            for (int jj = 0; jj < 4; ++jj) { const int t = tt * 16 + fq * 4 + jj; hloc[t * 256] = accx[c2][tt][jj] + accr[c2][tt][jj] * myH; pc[t * 256] = accr[c2][tt][jj] * myP; } }
        if (fq == 0) { float* As = (float*)(a.ws + WS_AS) + ct * 256 + c; float* Bs = (float*)(a.ws + WS_BS) + ct * 256 + c;
            if (!SAMPLE) { *As = cP; *Bs = cH; }
            else { const float h0s = INP(I_SLRU)[(size_t)(l * 32 + k.sb) * 256 + c]; a.out[O_SLRU + (size_t)(l * 32 + k.sb) * 256 + c] = cP * h0s + cH; *As = cP; *Bs = h0s; } }
    }
    __syncthreads();
}

constexpr int RS4 = 264;
constexpr int TS = 72;
template <bool SAMPLE> DI void m1_u_item(const KArgs& a, int l, int ct, unsigned char* lds) {
    constexpr int L = SAMPLE ? 32 : 64, NP = L * 32 / 512;
    const int tid = otid(), lane = tid & 63, w = tid >> 6, fr = lane & 15, fq = lane >> 4;
    const CT k = ct_decode(ct);
    bf16* KR = (bf16*)lds;
    bf16* VR = KR + 64 * RS4;
    const bf16* z = (const bf16*)(a.ws + WS_Z);
    {   u32x4 kr[NP], vr[NP];
#pragma unroll
        for (int i = 0; i < NP; ++i) { const int p = tid + 512 * i, j = p >> 5, col = (p & 31) * 8;
            kr[i] = *(const u32x4*)(z + (size_t)(k.row0 + j) * ZS + C_BK + col); vr[i] = *(const u32x4*)(z + (size_t)(k.row0 + j) * ZS + C_BV + col); }
#pragma unroll
        for (int i = 0; i < NP; ++i) { const int p = tid + 512 * i, j = p >> 5, col = (p & 31) * 8;
            const float wj = exp2f((float)(L - 1 - j) * lg2_gamma(col >> 6)) * 0.125f; u32x4 kw;
            kw.x = pk2(lo16f(kr[i].x) * wj, hi16f(kr[i].x) * wj); kw.y = pk2(lo16f(kr[i].y) * wj, hi16f(kr[i].y) * wj); kw.z = pk2(lo16f(kr[i].z) * wj, hi16f(kr[i].z) * wj); kw.w = pk2(lo16f(kr[i].w) * wj, hi16f(kr[i].w) * wj);
            *(u32x4*)(KR + j * RS4 + col) = kw; *(u32x4*)(VR + j * RS4 + col) = vr[i]; } }
    __syncthreads();
    const int hh = w >> 1, dtb = (w & 1) * 2;
#pragma unroll
    for (int d2 = 0; d2 < 2; ++d2) {
        bf16x8 kf[L / 32];
#pragma unroll
        for (int ks = 0; ks < L / 32; ++ks) { const bf16* kb = KR + (ks * 32 + fq * 8) * RS4 + hh * 64 + (dtb + d2) * 16; kf[ks] = cat8(tr_blk(kb, RS4, fr), tr_blk(kb + 4 * RS4, RS4, fr)); }
        const int d = (dtb + d2) * 16 + fr;
#pragma unroll
        for (int et = 0; et < 4; ++et) { f32x4 acc = (f32x4){0.f, 0.f, 0.f, 0.f};
#pragma unroll
            for (int ks = 0; ks < L / 32; ++ks) { const bf16* vb = VR + (ks * 32 + fq * 8) * RS4 + hh * 64 + et * 16; const bf16x8 vf = cat8(tr_blk(vb, RS4, fr), tr_blk(vb + 4 * RS4, RS4, fr)); acc = MFMA16(vf, kf[ks], acc); }
            if (!SAMPLE) *(f32x4*)((float*)(a.ws + WS_U) + ((size_t)(ct * 4 + hh) * 64 + d) * 64 + et * 16 + fq * 4) = acc;
            else { const size_t idx = (((size_t)(l * 32 + k.sb) * 4 + hh) * 64 + d) * 64 + et * 16 + fq * 4; const float g32 = exp2f(32.0f * lg2_gamma(hh));
                const f32x4 s0 = *(const f32x4*)(INP(I_SRET) + idx); *(f32x4*)(a.out + O_SRET + idx) = s0 * g32 + acc; } }
    }
    __syncthreads();
}

template <bool SAMPLE> DI void m1_swa_item(const KArgs& a, int l, int ct, int kh, unsigned char* lds) {
    constexpr int NQT = SAMPLE ? 1 : 2, NKT = SAMPLE ? 10 : 12, NK = NKT * 16, NP = (NK * 8 + 511) / 512;
    const int tid = otid(), lane = tid & 63, w = tid >> 6, fr = lane & 15, fq = lane >> 4;
    const CT k = ct_decode(ct);
    bf16* KL = (bf16*)lds;
    bf16* VL = KL + 192 * TS;
    const bf16* z = (const bf16*)(a.ws + WS_Z);
    const int seq0 = k.n * 64 - 128;
    const int g = w >> 1, qbase = (w & 1) * (NQT * 16), hd = kh * 4 + g;
    u32x4 rk[NP], rv[NP];
#pragma unroll
    for (int i = 0; i < NP; ++i) { const int p = tid + 512 * i, key = p >> 3, d0 = (p & 7) * 8; rk[i] = (u32x4){0u, 0u, 0u, 0u}; rv[i] = rk[i];
        if (p < NK * 8) {
            if constexpr (!SAMPLE) { if (seq0 + key >= 0) { const bf16* zr = z + (size_t)(k.b * 8192 + seq0 + key) * ZS + kh * 64 + d0; rk[i] = *(const u32x4*)(zr + C_CK); rv[i] = *(const u32x4*)(zr + C_CV); } }
            else { if (key < 128) { const size_t off = (((size_t)(l * 32 + k.sb) * 128 + key) * 2 + kh) * 64 + d0; const float* ck = INP(I_CK) + off; const float* cv = INP(I_CV) + off;
                       rk[i] = pack8u(*(const f32x4*)ck, *(const f32x4*)(ck + 4)); rv[i] = pack8u(*(const f32x4*)cv, *(const f32x4*)(cv + 4)); }
                   else { const bf16* zr = z + (size_t)(k.row0 + key - 128) * ZS + kh * 64 + d0; rk[i] = *(const u32x4*)(zr + C_CK); rv[i] = *(const u32x4*)(zr + C_CV); } } } }
    bf16x8 qf[NQT][2];
#pragma unroll
    for (int qt = 0; qt < NQT; ++qt)
#pragma unroll
        for (int kk = 0; kk < 2; ++kk) qf[qt][kk] = *(const bf16x8*)(z + (size_t)(k.row0 + qbase + qt * 16 + fr) * ZS + C_CQ + hd * 64 + kk * 32 + fq * 8);
    const float slope = exp2f(-(float)(hd + 1)), sink = INP(I_SINK)[l * 8 + hd];
#pragma unroll
    for (int i = 0; i < NP; ++i) { const int p = tid + 512 * i, key = p >> 3, d0 = (p & 7) * 8; if (p < NK * 8) { *(u32x4*)(KL + key * TS + d0) = rk[i]; *(u32x4*)(VL + key * TS + d0) = rv[i]; } }
    __syncthreads();
    f32x4 S[NQT][NKT];
#pragma unroll
    for (int kt = 0; kt < NKT; ++kt) {
        const bf16x8 kf0 = *(const bf16x8*)(KL + (kt * 16 + fr) * TS + fq * 8), kf1 = *(const bf16x8*)(KL + (kt * 16 + fr) * TS + 32 + fq * 8);
#pragma unroll
        for (int qt = 0; qt < NQT; ++qt) { f32x4 sacc = (f32x4){0.f, 0.f, 0.f, 0.f}; sacc = MFMA16(kf0, qf[qt][0], sacc); sacc = MFMA16(kf1, qf[qt][1], sacc); S[qt][kt] = sacc; }
    }
    bf16x8 pf[NQT][NKT / 2];
#pragma unroll
    for (int qt = 0; qt < NQT; ++qt) {
        const int qi = qbase + qt * 16 + fr; float m = -3.0e38f;
#pragma unroll
        for (int kt = 0; kt < NKT; ++kt)
#pragma unroll
            for (int jj = 0; jj < 4; ++jj) { const int key = kt * 16 + fq * 4 + jj; const float dist = fabsf((float)(128 + qi - key)); float sv = S[qt][kt][jj] * 0.125f - slope * dist;
                if constexpr (!SAMPLE) { if (seq0 + key < 0) sv = -1e30f; }
                S[qt][kt][jj] = sv; m = fmaxf(m, sv); }
        m = fmaxf(m, __shfl_xor(m, 16)); m = fmaxf(m, __shfl_xor(m, 32)); m = fmaxf(m, sink);
        float sum = 0.f;
#pragma unroll
        for (int kt = 0; kt < NKT; ++kt)
#pragma unroll
            for (int jj = 0; jj < 4; ++jj) { const float e = __expf(S[qt][kt][jj] - m); S[qt][kt][jj] = e; sum += e; }
        sum += __shfl_xor(sum, 16); sum += __shfl_xor(sum, 32);
        const float inv = 1.0f / (sum + __expf(sink - m));
#pragma unroll
        for (int kb = 0; kb < NKT / 2; ++kb) pf[qt][kb] = pack8(S[qt][2 * kb] * inv, S[qt][2 * kb + 1] * inv);
    }
    bf16* ob = (bf16*)(a.ws + WS_OHB);
#pragma unroll
    for (int dt = 0; dt < 4; ++dt) {
        f32x4 o[NQT];
#pragma unroll
        for (int qt = 0; qt < NQT; ++qt) o[qt] = (f32x4){0.f, 0.f, 0.f, 0.f};
#pragma unroll
        for (int kb = 0; kb < NKT / 2; ++kb) {
            const bf16* vb = VL + (kb * 32 + fq * 4) * TS + dt * 16;
            const bf16x8 vf = cat8(tr_blk(vb, TS, fr), tr_blk(vb + 16 * TS, TS, fr));
#pragma unroll
            for (int qt = 0; qt < NQT; ++qt) o[qt] = MFMA16(vf, pf[qt][kb], o[qt]);
        }
#pragma unroll
        for (int qt = 0; qt < NQT; ++qt) { u32x2 wv; wv.x = pk2(o[qt][0], o[qt][1]); wv.y = pk2(o[qt][2], o[qt][3]);
            *(u32x2*)(ob + (size_t)(k.row0 + qbase + qt * 16 + fr) * DM + 512 + hd * 64 + dt * 16 + fq * 4) = wv; }
    }
    __syncthreads();
}

DI void phase_m1(const KArgs& a, int l, unsigned char* lds) {
    for (int it = blockIdx.x; it < 1152; it += gridDim.x) {
        if (it < 576) { const int ct = it >> 1, kh = it & 1; if (ct < 256) m1_swa_item<false>(a, l, ct, kh, lds); else m1_swa_item<true>(a, l, ct, kh, lds); }
        else if (it < 864) { const int ct = it - 576; if (ct < 256) m1_a_item<false>(a, l, ct, lds); else m1_a_item<true>(a, l, ct, lds); }
        else { const int ct = it - 864; if (ct < 256) m1_u_item<false>(a, l, ct, lds); else m1_u_item<true>(a, l, ct, lds); }
    }
}

DI void phase_m2(const KArgs& a, int l, unsigned char* lds) {
    const int tid = otid(), lane = tid & 63, w = __builtin_amdgcn_readfirstlane(tid >> 6), seg = w >> 1, el = tid & 127;
    float* xs = (float*)lds;
    for (int eb = blockIdx.x; eb < 256; eb += gridDim.x) {
        const int e0 = eb * 128, b = e0 >> 14, hh = (e0 & 16383) >> 12, de0 = e0 & 4095;
        const float g = exp2f(64.0f * lg2_gamma(hh)), g32 = exp2f(2048.0f * lg2_gamma(hh));
        float* Ub = (float*)(a.ws + WS_U) + ((size_t)(b * 128 + seg * 32) * 4 + hh) * 4096 + de0;
        float u[32];
#pragma unroll
        for (int i = 0; i < 32; ++i) u[i] = (Ub + (size_t)i * 16384)[el];
        float s = 0.f;
#pragma unroll
        for (int i = 0; i < 32; ++i) { const float t = u[i]; u[i] = s; s = g * s + t; }
        xs[seg * 128 + el] = s;
        __syncthreads();
        float c = 0.f;
#pragma unroll
        for (int q = 0; q < 3; ++q) if (q < seg) c = g32 * c + xs[q * 128 + el];
        float gp = 1.f;
#pragma unroll
        for (int i = 0; i < 32; ++i) { (Ub + (size_t)i * 16384)[el] = u[i] + gp * c; gp *= g; }
        if (seg == 3) (a.out + O_PRET + ((size_t)(l * 2 + b) * 4 + hh) * 4096 + de0)[el] = s + g32 * c;
        __syncthreads();
    }
    for (int pb = blockIdx.x; pb < 256; pb += gridDim.x) {
        const int b = pb >> 7, c0 = (pb * 2) & 255; const bool act = (w < 4) && (lane < 2); const int sg = w & 3;
        float* As = (float*)(a.ws + WS_AS) + (size_t)(b * 128 + sg * 32) * 256 + c0; float* Bs = (float*)(a.ws + WS_BS) + (size_t)(b * 128 + sg * 32) * 256 + c0;
        float av[32], bv[32]; float P = 1.f, H = 0.f;
        if (act) {
#pragma unroll
            for (int i = 0; i < 32; ++i) { av[i] = (As + i * 256)[lane]; bv[i] = (Bs + i * 256)[lane]; }
#pragma unroll
            for (int i = 0; i < 32; ++i) { const float ai = av[i], bi = bv[i]; av[i] = P; bv[i] = H; H = ai * H + bi; P = ai * P; }
            xs[512 + sg * 2 + lane] = P; xs[520 + sg * 2 + lane] = H;
        }
        __syncthreads();
        if (act) {
            float cin = 0.f;
#pragma unroll
            for (int q = 0; q < 3; ++q) if (q < sg) cin = xs[512 + q * 2 + lane] * cin + xs[520 + q * 2 + lane];
#pragma unroll
            for (int i = 0; i < 32; ++i) (Bs + i * 256)[lane] = av[i] * cin + bv[i];
            if (sg == 3) (a.out + O_PLRU + (size_t)(l * 2 + b) * 256 + c0)[lane] = P * cin + H;
        }
        __syncthreads();
    }
    {
        const bf16* z = (const bf16*)(a.ws + WS_Z);
        for (int i = blockIdx.x * 512 + tid; i < 1280 * 64; i += gridDim.x * 512) {
            const int r = i >> 6, c4 = (i & 63) * 4; int zrow; float* ok;
            if (r < 256) { const int b = r >> 7, wq = r & 127; zrow = b * 8192 + 8064 + wq; ok = a.out + (c4 < 128 ? O_PK : O_PV) + ((size_t)(l * 2 + b) * 128 + wq) * 128; }
            else { const int rs = r - 256; zrow = MP + rs; ok = a.out + (c4 < 128 ? O_SK : O_SV) + ((size_t)l * 1024 + rs) * 128; }
            const u32x2 raw = *(const u32x2*)(z + (size_t)zrow * ZS + C_CK + c4);
            f32x4 o; o.x = __uint_as_float(raw.x << 16); o.y = __uint_as_float(raw.x & 0xffff0000u); o.z = __uint_as_float(raw.y << 16); o.w = __uint_as_float(raw.y & 0xffff0000u);
            *(f32x4*)(ok + (c4 & 127)) = o;
        }
    }
}

template <bool SAMPLE> DI void m3_item(const KArgs& a, int l, int ct, unsigned char* lds) {
    constexpr int L = SAMPLE ? 32 : 64, NIT = SAMPLE ? 1 : 2, NJT = L / 16, NPV = L * 32 / 512;
    const int tid = otid(), lane = tid & 63, w = tid >> 6, fr = lane & 15, fq = lane >> 4;
    const CT k = ct_decode(ct);
    const bf16* z = (const bf16*)(a.ws + WS_Z);
    bf16* ob = (bf16*)(a.ws + WS_OHB);
    bf16* VR = (bf16*)lds;
    bf16* SR = VR + 64 * RS4;
    const int hh = w >> 1, half = w & 1; const float lg = lg2_gamma(hh);
    u32x4 vraw[NPV]; f32x4 sraw[8];
#pragma unroll
    for (int i = 0; i < NPV; ++i) { const int p = tid + 512 * i, j = p >> 5, col = (p & 31) * 8; vraw[i] = *(const u32x4*)(z + (size_t)(k.row0 + j) * ZS + C_BV + col); }
    { const float* Sp = SAMPLE ? INP(I_SRET) + (size_t)(l * 32 + k.sb) * 16384 : (const float*)(a.ws + WS_U) + (size_t)ct * 16384;
#pragma unroll
      for (int i = 0; i < 8; ++i) sraw[i] = *(const f32x4*)(Sp + (size_t)(tid + 512 * i) * 4); }
    bf16x8 qf[NIT][2], kf[NJT][2];
#pragma unroll
    for (int it = 0; it < NIT; ++it)
#pragma unroll
        for (int kk = 0; kk < 2; ++kk) qf[it][kk] = *(const bf16x8*)(z + (size_t)(k.row0 + half * (NIT * 16) + it * 16 + fr) * ZS + C_BQ + hh * 64 + kk * 32 + fq * 8);
#pragma unroll
    for (int jt = 0; jt < NJT; ++jt)
#pragma unroll
        for (int kk = 0; kk < 2; ++kk) kf[jt][kk] = *(const bf16x8*)(z + (size_t)(k.row0 + jt * 16 + fr) * ZS + C_BK + hh * 64 + kk * 32 + fq * 8);
    { const int c4 = (tid & 63) * 4; const f32x4 hin = *(const f32x4*)((const float*)(a.ws + WS_BS) + ct * 256 + c4);
#pragma unroll 4
      for (int t = tid >> 6; t < L; t += 8) { const size_t r = (size_t)(k.row0 + t);
          const f32x4 hl = *(const f32x4*)((const float*)(a.ws + WS_HLOC) + r * 256 + c4), pc = *(const f32x4*)((const float*)(a.ws + WS_PC) + r * 256 + c4);
          const u32x2 ag = *(const u32x2*)(z + r * ZS + C_AG + c4);
          const f32x4 hv = hl + pc * hin;
          u32x2 o; o.x = pk2(hv.x * gelu_tanh(lo16f(ag.x)), hv.y * gelu_tanh(hi16f(ag.x))); o.y = pk2(hv.z * gelu_tanh(lo16f(ag.y)), hv.w * gelu_tanh(hi16f(ag.y)));
          *(u32x2*)(ob + r * DM + c4) = o; } }
#pragma unroll
    for (int i = 0; i < NPV; ++i) { const int p = tid + 512 * i, j = p >> 5, col = (p & 31) * 8; *(u32x4*)(VR + j * RS4 + col) = vraw[i]; }
#pragma unroll
    for (int i = 0; i < 8; ++i) { const int p = tid + 512 * i, row = p >> 4, e0 = (p & 15) * 4; u32x2 wv; wv.x = pk2(sraw[i].x, sraw[i].y); wv.y = pk2(sraw[i].z, sraw[i].w); *(u32x2*)(SR + row * TS + e0) = wv; }
    __syncthreads();
    bf16x8 pf[NIT][NJT / 2];
    {   f32x4 S[NIT][NJT];
#pragma unroll
        for (int jt = 0; jt < NJT; ++jt) {
#pragma unroll
            for (int it = 0; it < NIT; ++it) { f32x4 sacc = (f32x4){0.f, 0.f, 0.f, 0.f}; sacc = MFMA16(kf[jt][0], qf[it][0], sacc); sacc = MFMA16(kf[jt][1], qf[it][1], sacc);
                const int i = half * (NIT * 16) + it * 16 + fr;
#pragma unroll
                for (int jj = 0; jj < 4; ++jj) { const int dij = i - (jt * 16 + fq * 4 + jj); sacc[jj] = dij >= 0 ? sacc[jj] * 0.125f * exp2f((float)dij * lg) : 0.f; }
                S[it][jt] = sacc; } }
#pragma unroll
        for (int it = 0; it < NIT; ++it)
#pragma unroll
            for (int jb = 0; jb < NJT / 2; ++jb) pf[it][jb] = pack8(S[it][2 * jb], S[it][2 * jb + 1]);
    }
    f32x4 o[NIT][4];
#pragma unroll
    for (int et = 0; et < 4; ++et) {
        f32x4 oi[NIT], oc[NIT];
#pragma unroll
        for (int it = 0; it < NIT; ++it) { oi[it] = (f32x4){0.f, 0.f, 0.f, 0.f}; oc[it] = (f32x4){0.f, 0.f, 0.f, 0.f}; }
#pragma unroll
        for (int jb = 0; jb < NJT / 2; ++jb) { const bf16* vb = VR + (jb * 32 + fq * 4) * RS4 + hh * 64 + et * 16; const bf16x8 vf = cat8(tr_blk(vb, RS4, fr), tr_blk(vb + 16 * RS4, RS4, fr));
#pragma unroll
            for (int it = 0; it < NIT; ++it) oi[it] = MFMA16(vf, pf[it][jb], oi[it]); }
#pragma unroll
        for (int kk = 0; kk < 2; ++kk) { const bf16* sb = SR + (hh * 64 + kk * 32 + fq * 8) * TS + et * 16; const bf16x8 sf = cat8(tr_blk(sb, TS, fr), tr_blk(sb + 4 * TS, TS, fr));
#pragma unroll
            for (int it = 0; it < NIT; ++it) oc[it] = MFMA16(sf, qf[it][kk], oc[it]); }
#pragma unroll
        for (int it = 0; it < NIT; ++it) { const int i = half * (NIT * 16) + it * 16 + fr; o[it][et] = oi[it] + oc[it] * exp2f((float)(i + 1) * lg); }
    }
#pragma unroll
    for (int it = 0; it < NIT; ++it) {
        const int i = half * (NIT * 16) + it * 16 + fr; const size_t r = (size_t)(k.row0 + i);
        float sm = 0.f;
#pragma unroll
        for (int et = 0; et < 4; ++et) sm += (o[it][et][0] + o[it][et][1]) + (o[it][et][2] + o[it][et][3]);
        sm += __shfl_xor(sm, 16); sm += __shfl_xor(sm, 32);
        const float mean = sm * (1.0f / 64.0f); float q = 0.f;
#pragma unroll
        for (int et = 0; et < 4; ++et) { o[it][et] = o[it][et] - mean; q += (o[it][et][0] * o[it][et][0] + o[it][et][1] * o[it][et][1]) + (o[it][et][2] * o[it][et][2] + o[it][et][3] * o[it][et][3]); }
        q += __shfl_xor(q, 16); q += __shfl_xor(q, 32);
        const float rstd = 1.0f / sqrtf(q * (1.0f / 64.0f) + LN_EPS);
#pragma unroll
        for (int et = 0; et < 4; ++et) { const int e = hh * 64 + et * 16 + fq * 4;
            const f32x4 gg = *(const f32x4*)(INP(I_GNG) + l * 256 + e), bb = *(const f32x4*)(INP(I_GNB) + l * 256 + e);
            const u32x2 bgr = *(const u32x2*)(z + r * ZS + C_BG + e);
            const float g0 = lo16f(bgr.x), g1 = hi16f(bgr.x), g2 = lo16f(bgr.y), g3 = hi16f(bgr.y);
            const f32x4 y = o[it][et] * rstd * gg + bb;
            u32x2 wv; wv.x = pk2(y.x * g0 * sigmoidf_(g0), y.y * g1 * sigmoidf_(g1)); wv.y = pk2(y.z * g2 * sigmoidf_(g2), y.w * g3 * sigmoidf_(g3));
            *(u32x2*)(ob + r * DM + 256 + e) = wv; }
    }
    __syncthreads();
}
DI void phase_m3(const KArgs& a, int l, unsigned char* lds) {
    for (int ct = blockIdx.x; ct < NCT; ct += gridDim.x) { if (ct < 256) m3_item<false>(a, l, ct, lds); else m3_item<true>(a, l, ct, lds); }
}

#define XB_TMO      128
#define XB_XCNT(j)  (256  + 64 * (j))
#define XB_XSUB(j)  (1280 + 64 * (j))
#define XB_XGEN(j)  (2304 + 64 * (j))
#define XB_TOP      3328
#define XB_TOPGEN   3392
#define XCD_BAR_WORDS 3456
#define XB_SPIN_CAP (1u << 18)

__device__ __forceinline__ unsigned xb_ld(unsigned* p)              { return __hip_atomic_load(p, __ATOMIC_RELAXED, __HIP_MEMORY_SCOPE_AGENT); }
__device__ __forceinline__ unsigned xb_add(unsigned* p, unsigned v) { return __hip_atomic_fetch_add(p, v, __ATOMIC_RELAXED, __HIP_MEMORY_SCOPE_AGENT); }
__device__ __forceinline__ unsigned xb_xcc_id() { return (unsigned)__builtin_amdgcn_s_getreg((3 << 11) | 20) & 0xFu; }
#define XB_SPIN(cond, bar) do { unsigned _sp = 0; while (cond) { __builtin_amdgcn_s_sleep(1); \
    if ((++_sp & 255u) == 0u) { if (xb_ld(&(bar)[XB_TMO])) break; if (_sp > XB_SPIN_CAP) { atomicAdd(&(bar)[XB_TMO], 1u); break; } } } } while (0)

struct XcdBarrier {
    unsigned* bar; unsigned x;
    volatile LAS unsigned* st;
};

__device__ __forceinline__ XcdBarrier xcd_barrier_post(unsigned* bar, volatile LAS unsigned* st) {
    XcdBarrier b; b.bar = bar; b.x = xb_xcc_id(); b.st = st;
    if (threadIdx.x == 0) (void)xb_add(&bar[XB_XCNT(b.x)], 1u);
    return b;
}
__device__ __forceinline__ void xcd_barrier_complete(unsigned* bar, unsigned x, unsigned& nloc, unsigned& nx) {
    const unsigned G = gridDim.x * gridDim.y * gridDim.z;
    unsigned sum, cnt, mine, sp = 0u;
    for (;;) {
        sum = 0u; cnt = 0u; mine = 0u;
#pragma unroll
        for (unsigned j = 0; j < 16; ++j) { const unsigned c = xb_ld(&bar[XB_XCNT(j)]); sum += c; cnt += (c > 0u) ? 1u : 0u; mine = (j == x) ? c : mine; }
        if (sum == G) break;
        __builtin_amdgcn_s_sleep(1);
        if ((++sp & 255u) == 0u) { if (xb_ld(&bar[XB_TMO])) break; if (sp > XB_SPIN_CAP) { atomicAdd(&bar[XB_TMO], 1u); break; } }
    }
    nloc = mine > 0u ? mine : 1u; nx = cnt > 0u ? cnt : 1u;
}

__device__ __forceinline__ void xcd_barrier(const XcdBarrier& b) {
    asm volatile("s_waitcnt vmcnt(0)" ::: "memory");
    __syncthreads();
    if (threadIdx.x == 0) {
        unsigned* bar = b.bar;
        __builtin_amdgcn_s_waitcnt(0);
        unsigned nloc = b.st[0], nx = b.st[1];
        if (nloc == 0u) { xcd_barrier_complete(bar, b.x, nloc, nx); b.st[0] = nloc; b.st[1] = nx; }
        const unsigned old = xb_add(&bar[XB_XSUB(b.x)], 1u);
        const unsigned gen = old / nloc;
        if (old + 1u == (gen + 1u) * nloc) {
            __builtin_amdgcn_fence(__ATOMIC_RELEASE, "agent");
            asm volatile("s_waitcnt vmcnt(0)" ::: "memory");
            const unsigned og = xb_add(&bar[XB_TOP], 1u);
            const unsigned tg = og / nx;
            if (og + 1u == (tg + 1u) * nx) xb_add(&bar[XB_TOPGEN], 1u);
            else XB_SPIN(xb_ld(&bar[XB_TOPGEN]) == tg, bar);
            __builtin_amdgcn_fence(__ATOMIC_ACQUIRE, "agent");
            xb_add(&bar[XB_XGEN(b.x)], 1u);
            asm volatile("s_waitcnt vmcnt(0)" ::: "memory");
        } else {
            XB_SPIN(xb_ld(&bar[XB_XGEN(b.x)]) == gen, bar);
            __builtin_amdgcn_fence(__ATOMIC_ACQUIRE, "agent");
            asm volatile("s_waitcnt vmcnt(0)" ::: "memory");
        }
    }
    __syncthreads();
}

__global__ void __launch_bounds__(512, 2) fwd_kernel(KArgs a) {
    extern __shared__ __attribute__((aligned(16))) unsigned char lds[];
    cg::grid_group grid = cg::this_grid();
    const int tid = otid(), lane = tid & 63, wave = __builtin_amdgcn_readfirstlane(tid >> 6);
    const int G = gridDim.x, bx = blockIdx.x;
    if (tid == 0) { LAS unsigned long long* tb = (LAS unsigned long long*)((LAS unsigned char*)lds + TBL_OFF);
#pragma unroll
        for (int i = 0; i < N_IN; ++i) tb[i] = (unsigned long long)a.in[i]; }
    if (tid < 2) ((LAS unsigned*)((LAS unsigned char*)lds + MISC_OFF))[tid] = 0u;
    __syncthreads();
    XcdBarrier bar = xcd_barrier_post((unsigned*)(a.ws + WS_CTL), (volatile LAS unsigned*)((LAS unsigned char*)lds + MISC_OFF));
    phase_p0(a, lds, wave, lane);
    grid.sync();
    bf16* ohb = (bf16*)(a.ws + WS_OHB);
#pragma unroll 1
    for (int l = 0; l < NL; ++l) {
        unsigned char* wl = a.ws + WS_W + (size_t)l * WL_BYTES;
        {
            pg8::Gemm g{ohb, (const bf16*)(wl + WL_IN), MTOK, DIN, DM}; typedef pg8::SplitOrder<68, 68, 9, 1, 16> SO; SO S; S.init(G, bx);
            pg8::EpiZ E{(bf16*)(a.ws + WS_Z), DIN};
            pg8::gemm_phase<pg8::EpiZ, SO, true, true>((LAS unsigned char*)lds, g, S, E);
        }
        xcd_barrier(bar);
        phase_m1(a, l, lds);
        xcd_barrier(bar);
        phase_m2(a, l, lds);
        xcd_barrier(bar);
        phase_m3(a, l, lds);
        xcd_barrier(bar);
        {
            pg8::Gemm g{ohb, (const bf16*)(wl + WL_OUT), MTOK, DM, DM}; typedef pg8::SplitOrder<68, 64, 4, 4, 16> SO; SO S; S.init(G, bx);
            pg8::EpiRes<16> E{a.out + O_Y, (float*)(a.ws + WS_SLAB), DM, MP};
            pg8::gemm_phase<pg8::EpiRes<16>, SO, true, true>((LAS unsigned char*)lds, g, S, E);
        }
        xcd_barrier(bar);
        phase_ln<4>(a, INP(I_LN1G) + l * DM, INP(I_LN1B) + l * DM, true, wave, lane);
        xcd_barrier(bar);
        {
            pg8::Gemm g{ohb, (const bf16*)(wl + WL_GU), MTOK, 2 * DFF, DM}; typedef pg8::SplitOrder<68, 68, 22, 1, 16> SO; SO S; S.init(G, bx);
            pg8::EpiGU E{(bf16*)(a.ws + WS_G), DFF};
            pg8::gemm_phase<pg8::EpiGU, SO, true, true>((LAS unsigned char*)lds, g, S, E);
        }
        xcd_barrier(bar);
        {
            pg8::Gemm g{(const bf16*)(a.ws + WS_G), (const bf16*)(wl + WL_D), MTOK, DM, DFF}; typedef pg8::SplitOrder<68, 64, 4, 11, 44> SO; SO S; S.init(G, bx);
            pg8::EpiRes<44> E{a.out + O_Y, (float*)(a.ws + WS_SLAB), DM, MP};
            pg8::gemm_phase<pg8::EpiRes<44>, SO, true, true>((LAS unsigned char*)lds, g, S, E);
        }
        xcd_barrier(bar);
        phase_ln<11>(a, INP(I_LN2G) + l * DM, INP(I_LN2B) + l * DM, l + 1 < NL, wave, lane);
        if (l + 1 < NL) xcd_barrier(bar);
    }
}

extern "C" void kernel_launch(void* const* d_in, const int* in_sizes, int n_in, void* d_out, int out_size, void* d_ws, size_t ws_size, hipStream_t stream) {
    static int grid = 0;
    if (grid == 0) {
        if (n_in != N_IN || out_size != (int)O_END || ws_size < WS_END) { fprintf(stderr, "kernel_launch: unexpected sizes n_in %d out %d ws %zu\n", n_in, out_size, ws_size); grid = -1; return; }
        int dev = 0, cus = 0, per_cu = 0;
        if (hipGetDevice(&dev) != hipSuccess || hipDeviceGetAttribute(&cus, hipDeviceAttributeMultiprocessorCount, dev) != hipSuccess) { grid = -1; return; }
        if (hipFuncSetAttribute((const void*)fwd_kernel, hipFuncAttributeMaxDynamicSharedMemorySize, LDS_BYTES) != hipSuccess) { fprintf(stderr, "kernel_launch: hipFuncSetAttribute failed\n"); grid = -1; return; }
        if (hipOccupancyMaxActiveBlocksPerMultiprocessor(&per_cu, (const void*)fwd_kernel, 512, LDS_BYTES) != hipSuccess || per_cu < 1) { fprintf(stderr, "kernel_launch: occupancy query says %d\n", per_cu); per_cu = 1; }
        (void)hipGetLastError();
        grid = cus;
    }
    if (grid < 0) return;
    if (hipMemsetAsync((char*)d_ws + WS_CTL, 0, CTL_BYTES, stream) != hipSuccess) { fprintf(stderr, "kernel_launch: memset failed\n"); return; }
    KArgs a{};
    for (int i = 0; i < N_IN; ++i) a.in[i] = (const float*)d_in[i];
    a.out = (float*)d_out; a.ws = (unsigned char*)d_ws;
    void* args[] = {&a};
    hipError_t e = hipLaunchCooperativeKernel((const void*)fwd_kernel, dim3(grid), dim3(512), args, LDS_BYTES, stream);
    if (e != hipSuccess) fprintf(stderr, "cooperative launch failed: %s (grid %d)\n", hipGetErrorString(e), grid);
}
```
